# Optimizing an MI355X kernel written in HIP

```python
import math
import jax
import jax.numpy as jnp
from jax import lax
import numpy as np

D_MODEL = 1024
BATCH = 4
SEQ = 8192
DEPTH = 4

GRID_W = 64
CTX_LEN = 256
HEAD_DIM = 64
Q_BLOCK = 128
ROPE_THETA = 10000.0
EPS = 1e-6
MIX_HALF = D_MODEL // 2
NA_HEADS = MIX_HALF // HEAD_DIM
NA_WIN_R = 8
NA_WIN_C = 16
DA_VDIM = 2 * HEAD_DIM
DA_HEADS = MIX_HALF // DA_VDIM
GQA_Q_HEADS = MIX_HALF // HEAD_DIM
GQA_KV_HEADS = GQA_Q_HEADS // 4
HY_WIDTH = MIX_HALF
HY_EMB_DIM = 33
HY_FILTER_ORDER = 64
HY_FAST_DECAY = 0.3
HY_SLOW_DECAY = 1.5
HY_DECAY_TARGET = 1e-2
FFN_HIDDEN = ((8 * D_MODEL // 3 + 255) // 256) * 256

NA_WIDTH = NA_HEADS * HEAD_DIM
DA_QK_WIDTH = DA_HEADS * 2 * HEAD_DIM
DA_V_WIDTH = DA_HEADS * DA_VDIM
EVEN_IN = 3 * NA_WIDTH + 2 * DA_QK_WIDTH + DA_V_WIDTH
EVEN_MIX = NA_WIDTH + DA_V_WIDTH
GQA_Q_WIDTH = GQA_Q_HEADS * HEAD_DIM
GQA_KV_WIDTH = GQA_KV_HEADS * HEAD_DIM
ODD_IN = GQA_Q_WIDTH + 2 * GQA_KV_WIDTH + 3 * HY_WIDTH
ODD_MIX = GQA_Q_WIDTH + HY_WIDTH
N_EVEN = (DEPTH + 1) // 2
N_ODD = DEPTH // 2

kernel_name = 'hybrid_na_diff_gqa_hyena_dit'

F32 = jnp.float32


def rms_norm(x, gain=None):
    xf = x.astype(F32)
    y = xf * lax.rsqrt(jnp.mean(xf * xf, axis=-1, keepdims=True) + EPS)
    if gain is not None:
        y = y * gain.astype(F32)
    return y.astype(x.dtype)


def modulate(x, shift, scale):
    return rms_norm(x) * (1 + scale) + shift


def split_heads(x, n, d):
    b, l = x.shape[:2]
    return x.reshape(b, l, n, d).transpose(0, 2, 1, 3)


def merge_heads(x):
    b, h, l, d = x.shape
    return x.transpose(0, 2, 1, 3).reshape(b, l, h * d)


def dwconv3(x, w, b):
    xp = jnp.pad(x, ((0, 0), (1, 1), (0, 0)))
    return xp[:, :-2] * w[0] + xp[:, 1:-1] * w[1] + xp[:, 2:] * w[2] + b


def axial_rope(length, head_dim):
    t = jnp.arange(length, dtype=jnp.int32)
    row = (t // GRID_W).astype(F32)
    col = (t % GRID_W).astype(F32)
    n_pairs = head_dim // 4
    inv_freq = ROPE_THETA ** (-jnp.arange(n_pairs, dtype=F32) / n_pairs)
    ang = jnp.concatenate([row[:, None] * inv_freq, col[:, None] * inv_freq], axis=-1)
    return jnp.cos(ang), jnp.sin(ang)


def apply_rope(x, cos, sin):
    xf = x.astype(F32).reshape(x.shape[:-1] + (x.shape[-1] // 2, 2))
    x0, x1 = xf[..., 0], xf[..., 1]
    out = jnp.stack([x0 * cos - x1 * sin, x0 * sin + x1 * cos], axis=-1)
    return out.reshape(x.shape).astype(x.dtype)


def sweep_query_blocks(fn, *qs):
    b, h, l = qs[0].shape[:3]
    n = l // Q_BLOCK
    blocks = tuple(jnp.moveaxis(q.reshape(b, h, n, Q_BLOCK, q.shape[-1]), 2, 0) for q in qs)
    out = lax.map(lambda qb: fn(*qb), blocks)
    return jnp.moveaxis(out, 0, 2).reshape(b, h, l, out.shape[-1])


def attend(q, k, v):
    scale = q.shape[-1] ** -0.5
    s = jnp.einsum('bhqd,bhsd->bhqs', q, k).astype(F32) * scale
    p = jax.nn.softmax(s, axis=-1).astype(v.dtype)
    return jnp.einsum('bhqs,bhsd->bhqd', p, v)


def diff_attend(q1, q2, k1, k2, v, lam):
    scale = q1.shape[-1] ** -0.5
    p1 = jax.nn.softmax(jnp.einsum('bhqd,bhsd->bhqs', q1, k1).astype(F32) * scale, axis=-1)
    p2 = jax.nn.softmax(jnp.einsum('bhqd,bhsd->bhqs', q2, k2).astype(F32) * scale, axis=-1)
    return jnp.einsum('bhqs,bhsd->bhqd', (p1 - lam * p2).astype(v.dtype), v)


def gqa_attend(q, k, v):
    b, hq, nq, d = q.shape
    hkv = k.shape[1]
    qg = q.reshape(b, hkv, hq // hkv, nq, d)
    s = jnp.einsum('bkgqd,bksd->bkgqs', qg, k).astype(F32) * (d ** -0.5)
    p = jax.nn.softmax(s, axis=-1).astype(v.dtype)
    return jnp.einsum('bkgqs,bksd->bkgqd', p, v).reshape(b, hq, nq, d)


def neighbourhood_attention(q, k, v, k_ctx, v_ctx, rpb):
    b, h, l, d = q.shape
    rows = l // GRID_W
    win_r = min(NA_WIN_R, rows)
    n_win = win_r * NA_WIN_C
    scale = d ** -0.5
    qg = q.reshape(b, h, rows, GRID_W, d)
    kg = k.reshape(b, h, rows, GRID_W, d)
    vg = v.reshape(b, h, rows, GRID_W, d)
    row_start = jnp.clip(jnp.arange(rows) - win_r // 2, 0, rows - win_r)
    col_ids = jnp.arange(GRID_W)
    col_start = jnp.clip(col_ids - NA_WIN_C // 2, 0, GRID_W - NA_WIN_C)
    col_idx = col_start[:, None] + jnp.arange(NA_WIN_C)
    col_off = col_idx - col_ids[:, None] + NA_WIN_C - 1
    rpb32 = rpb.astype(F32)

    def one_row(args):
        q_row, r, r0 = args
        k_rows = lax.dynamic_slice_in_dim(kg, r0, win_r, axis=2)
        v_rows = lax.dynamic_slice_in_dim(vg, r0, win_r, axis=2)
        k_win = k_rows[:, :, :, col_idx]
        v_win = v_rows[:, :, :, col_idx]
        row_off = r0 + jnp.arange(win_r) - r + NA_WIN_R - 1
        bias = rpb32[:, row_off[None, :, None], col_off[:, None, :]]
        s_win = jnp.einsum('bhwd,bhrwcd->bhwrc', q_row, k_win).astype(F32) * scale + bias
        s_ctx = jnp.einsum('bhwd,bhsd->bhws', q_row, k_ctx).astype(F32) * scale
        s = jnp.concatenate([s_win.reshape(b, h, GRID_W, n_win), s_ctx], axis=-1)
        p = jax.nn.softmax(s, axis=-1).astype(v.dtype)
        p_win = p[..., :n_win].reshape(b, h, GRID_W, win_r, NA_WIN_C)
        return (jnp.einsum('bhwrc,bhrwcd->bhwd', p_win, v_win)
                + jnp.einsum('bhws,bhsd->bhwd', p[..., n_win:], v_ctx))

    out = lax.map(one_row, (jnp.moveaxis(qg, 2, 0), jnp.arange(rows), row_start))
    return jnp.moveaxis(out, 0, 2).reshape(b, h, l, d)


def hyena_filter(length, w1, b1, w2, b2, w3, b3, w4, freq):
    t = jnp.linspace(0.0, 1.0, length, dtype=F32)[:, None]
    bands = (HY_EMB_DIM - 1) // 2
    w = 2.0 * math.pi * jnp.arange(length, dtype=F32)[:, None] / length
    f = jnp.linspace(1e-4, bands - 1, bands, dtype=F32)[None, :]
    z = jnp.concatenate([t, jnp.cos(f * w), -jnp.sin(f * w)], axis=-1)
    fr = freq.astype(F32)
    hdn = jnp.sin(fr * (z @ w1.astype(F32) + b1.astype(F32)))
    hdn = jnp.sin(fr * (hdn @ w2.astype(F32) + b2.astype(F32)))
    hdn = jnp.sin(fr * (hdn @ w3.astype(F32) + b3.astype(F32)))
    hdn = hdn @ w4.astype(F32)
    max_decay = math.log(HY_DECAY_TARGET) / HY_FAST_DECAY
    min_decay = math.log(HY_DECAY_TARGET) / HY_SLOW_DECAY
    deltas = jnp.linspace(min_decay, max_decay, HY_WIDTH, dtype=F32)
    decay = jnp.exp(-t * jnp.abs(deltas))
    h_fwd = hdn[:, :HY_WIDTH] * decay
    h_bwd = hdn[:, HY_WIDTH:] * decay
    k_two = jnp.concatenate([h_fwd, jnp.zeros((1, HY_WIDTH), F32), h_bwd[:0:-1]], axis=0)
    return k_two / jnp.sum(jnp.abs(k_two), axis=0, keepdims=True)


def hyena(u, conv_w, conv_b, w1, b1, w2, b2, w3, b3, w4, freq, skip):
    length = u.shape[1]
    u = dwconv3(u, conv_w, conv_b)
    x0, x1, val = jnp.split(u, 3, axis=-1)
    z = (val * x1).astype(F32)
    kf = jnp.fft.rfft(hyena_filter(length, w1, b1, w2, b2, w3, b3, w4, freq), n=2 * length, axis=0)
    zf = jnp.fft.rfft(z, n=2 * length, axis=1)
    y = jnp.fft.irfft(zf * kf, n=2 * length, axis=1)[:, :length]
    return (x0.astype(F32) * (y + skip.astype(F32) * z)).astype(u.dtype)


def even_mixer(h_l, h_c, w_in, w_out, na_qg, na_kg, rpb, da_qg, da_kg, lq1, lk1, lq2, lk2, subln,
               lam_init, cos, sin, with_ctx):
    offs = [NA_WIDTH, 2 * NA_WIDTH, 3 * NA_WIDTH, 3 * NA_WIDTH + DA_QK_WIDTH, 3 * NA_WIDTH + 2 * DA_QK_WIDTH]
    qa_l, ka_l, va_l, qb_l, kb_l, vb_l = jnp.split(h_l @ w_in, offs, axis=-1)
    qa_c, ka_c, va_c, qb_c, kb_c, vb_c = jnp.split(h_c @ w_in, offs, axis=-1)
    qa_l = rms_norm(split_heads(qa_l, NA_HEADS, HEAD_DIM), na_qg)
    ka_l = rms_norm(split_heads(ka_l, NA_HEADS, HEAD_DIM), na_kg)
    va_l = split_heads(va_l, NA_HEADS, HEAD_DIM)
    ka_c = rms_norm(split_heads(ka_c, NA_HEADS, HEAD_DIM), na_kg)
    va_c = split_heads(va_c, NA_HEADS, HEAD_DIM)
    ya_l = neighbourhood_attention(qa_l, ka_l, va_l, ka_c, va_c, rpb)
    lam = (jnp.exp(jnp.sum(lq1.astype(F32) * lk1.astype(F32)))
           - jnp.exp(jnp.sum(lq2.astype(F32) * lk2.astype(F32))) + lam_init)
    qb_l = apply_rope(rms_norm(split_heads(qb_l, 2 * DA_HEADS, HEAD_DIM), da_qg), cos, sin)
    kb_l = apply_rope(rms_norm(split_heads(kb_l, 2 * DA_HEADS, HEAD_DIM), da_kg), cos, sin)
    vb_l = split_heads(vb_l, DA_HEADS, DA_VDIM)
    kb_c = rms_norm(split_heads(kb_c, 2 * DA_HEADS, HEAD_DIM), da_kg)
    vb_c = split_heads(vb_c, DA_HEADS, DA_VDIM)
    k1_all = jnp.concatenate([kb_l[:, 0::2], kb_c[:, 0::2]], axis=2)
    k2_all = jnp.concatenate([kb_l[:, 1::2], kb_c[:, 1::2]], axis=2)
    v_all = jnp.concatenate([vb_l, vb_c], axis=2)
    yb_l = sweep_query_blocks(lambda q1, q2: diff_attend(q1, q2, k1_all, k2_all, v_all, lam),
                              qb_l[:, 0::2], qb_l[:, 1::2])
    y_l = jnp.concatenate([merge_heads(ya_l), merge_heads(rms_norm(yb_l, subln) * (1.0 - lam_init))],
                          axis=-1) @ w_out
    if not with_ctx:
        return y_l, None
    qa_c = rms_norm(split_heads(qa_c, NA_HEADS, HEAD_DIM), na_qg)
    ya_c = attend(qa_c, ka_c, va_c)
    qb_c = rms_norm(split_heads(qb_c, 2 * DA_HEADS, HEAD_DIM), da_qg)
    yb_c = diff_attend(qb_c[:, 0::2], qb_c[:, 1::2], kb_c[:, 0::2], kb_c[:, 1::2], vb_c, lam)
    y_c = jnp.concatenate([merge_heads(ya_c), merge_heads(rms_norm(yb_c, subln) * (1.0 - lam_init))],
                          axis=-1) @ w_out
    return y_l, y_c


def odd_mixer(h_l, h_c, w_in, w_out, qg, kg, conv_w, conv_b, w1, b1, w2, b2, w3, b3, w4, freq, skip,
              cos, sin, with_ctx):
    offs = [GQA_Q_WIDTH, GQA_Q_WIDTH + GQA_KV_WIDTH, GQA_Q_WIDTH + 2 * GQA_KV_WIDTH]
    q_l, k_l, v_l, hy_l = jnp.split(h_l @ w_in, offs, axis=-1)
    q_c, k_c, v_c, hy_c = jnp.split(h_c @ w_in, offs, axis=-1)
    q_l = apply_rope(rms_norm(split_heads(q_l, GQA_Q_HEADS, HEAD_DIM), qg), cos, sin)
    k_l = apply_rope(rms_norm(split_heads(k_l, GQA_KV_HEADS, HEAD_DIM), kg), cos, sin)
    v_l = split_heads(v_l, GQA_KV_HEADS, HEAD_DIM)
    k_c = rms_norm(split_heads(k_c, GQA_KV_HEADS, HEAD_DIM), kg)
    v_c = split_heads(v_c, GQA_KV_HEADS, HEAD_DIM)
    k_all = jnp.concatenate([k_l, k_c], axis=2)
    v_all = jnp.concatenate([v_l, v_c], axis=2)
    yc_l = sweep_query_blocks(lambda qb: gqa_attend(qb, k_all, v_all), q_l)
    yd_l = hyena(hy_l, conv_w, conv_b, w1, b1, w2, b2, w3, b3, w4, freq, skip)
    y_l = jnp.concatenate([merge_heads(yc_l), yd_l], axis=-1) @ w_out
    if not with_ctx:
        return y_l, None
    q_c = rms_norm(split_heads(q_c, GQA_Q_HEADS, HEAD_DIM), qg)
    yc_c = gqa_attend(q_c, k_c, v_c)
    yd_c = hyena(hy_c, conv_w, conv_b, w1, b1, w2, b2, w3, b3, w4, freq, skip)
    y_c = jnp.concatenate([merge_heads(yc_c), yd_c], axis=-1) @ w_out
    return y_l, y_c


def conv_ffn(h, w_up, conv_w, conv_b, w_down):
    g, v = jnp.split(h @ w_up, 2, axis=-1)
    g = dwconv3(g, conv_w, conv_b)
    return (jax.nn.silu(g) * v) @ w_down


def setup_inputs(seed: int = 0) -> dict:
    key = jax.random.key(seed)
    D = D_MODEL
    specs = [
        ('x', (BATCH, SEQ, D), 1.0, 0.0),
        ('c', (BATCH, D), 1.0, 0.0),
        ('ctx', (BATCH, CTX_LEN, D), 1.0, 0.0),
        ('c_ctx', (D,), 1.0, 0.0),
        ('w_ada', (DEPTH, D, 6 * D), D ** -0.5, 0.0),
        ('b_ada', (DEPTH, 6 * D), 0.02, 0.0),
        ('w_up', (DEPTH, D, 2 * FFN_HIDDEN), D ** -0.5, 0.0),
        ('ffn_conv_w', (DEPTH, 3, FFN_HIDDEN), 3 ** -0.5, 0.0),
        ('ffn_conv_b', (DEPTH, FFN_HIDDEN), 0.02, 0.0),
        ('w_down', (DEPTH, FFN_HIDDEN, D), FFN_HIDDEN ** -0.5, 0.0),
        ('w_in_e', (N_EVEN, D, EVEN_IN), D ** -0.5, 0.0),
        ('w_out_e', (N_EVEN, EVEN_MIX, D), EVEN_MIX ** -0.5, 0.0),
        ('na_q_gain', (N_EVEN, HEAD_DIM), 0.05, 1.0),
        ('na_k_gain', (N_EVEN, HEAD_DIM), 0.05, 1.0),
        ('na_rpb', (N_EVEN, NA_HEADS, 2 * NA_WIN_R - 1, 2 * NA_WIN_C - 1), 0.02, 0.0),
        ('da_q_gain', (N_EVEN, HEAD_DIM), 0.05, 1.0),
        ('da_k_gain', (N_EVEN, HEAD_DIM), 0.05, 1.0),
        ('da_lambda_q1', (N_EVEN, HEAD_DIM), 0.1, 0.0),
        ('da_lambda_k1', (N_EVEN, HEAD_DIM), 0.1, 0.0),
        ('da_lambda_q2', (N_EVEN, HEAD_DIM), 0.1, 0.0),
        ('da_lambda_k2', (N_EVEN, HEAD_DIM), 0.1, 0.0),
        ('da_subln_gain', (N_EVEN, DA_VDIM), 0.05, 1.0),
        ('w_in_o', (N_ODD, D, ODD_IN), D ** -0.5, 0.0),
        ('w_out_o', (N_ODD, ODD_MIX, D), ODD_MIX ** -0.5, 0.0),
        ('gqa_q_gain', (N_ODD, HEAD_DIM), 0.05, 1.0),
        ('gqa_k_gain', (N_ODD, HEAD_DIM), 0.05, 1.0),
        ('hy_conv_w', (N_ODD, 3, 3 * HY_WIDTH), 3 ** -0.5, 0.0),
        ('hy_conv_b', (N_ODD, 3 * HY_WIDTH), 0.02, 0.0),
        ('hy_w1', (N_ODD, HY_EMB_DIM, HY_FILTER_ORDER), HY_EMB_DIM ** -0.5, 0.0),
        ('hy_b1', (N_ODD, HY_FILTER_ORDER), HY_EMB_DIM ** -0.5, 0.0),
        ('hy_w2', (N_ODD, HY_FILTER_ORDER, HY_FILTER_ORDER), HY_FILTER_ORDER ** -0.5, 0.0),
        ('hy_b2', (N_ODD, HY_FILTER_ORDER), HY_FILTER_ORDER ** -0.5, 0.0),
        ('hy_w3', (N_ODD, HY_FILTER_ORDER, HY_FILTER_ORDER), HY_FILTER_ORDER ** -0.5, 0.0),
        ('hy_b3', (N_ODD, HY_FILTER_ORDER), HY_FILTER_ORDER ** -0.5, 0.0),
        ('hy_w4', (N_ODD, HY_FILTER_ORDER, 2 * HY_WIDTH), HY_FILTER_ORDER ** -0.5, 0.0),
        ('hy_freq', (N_ODD, HY_FILTER_ORDER), 0.05, 1.0),
        ('hy_skip', (N_ODD, HY_WIDTH), 1.0, 0.0),
    ]
    keys = jax.random.split(key, len(specs))
    return {name: off + scale * jax.random.normal(keys[i], shape, F32)
            for i, (name, shape, scale, off) in enumerate(specs)}


def reference(x, c, ctx, c_ctx, w_ada, b_ada, w_up, ffn_conv_w, ffn_conv_b, w_down, w_in_e, w_out_e,
              na_q_gain, na_k_gain, na_rpb, da_q_gain, da_k_gain, da_lambda_q1, da_lambda_k1, da_lambda_q2,
              da_lambda_k2, da_subln_gain, w_in_o, w_out_o, gqa_q_gain, gqa_k_gain, hy_conv_w, hy_conv_b,
              hy_w1, hy_b1, hy_w2, hy_b2, hy_w3, hy_b3, hy_w4, hy_freq, hy_skip):
    cos, sin = axial_rope(x.shape[1], HEAD_DIM)
    x_l, x_c = x, ctx
    for layer in range(DEPTH):
        with_ctx = layer < DEPTH - 1
        mod_l = (jax.nn.silu(c) @ w_ada[layer] + b_ada[layer])[:, None, :]
        mod_c = jax.nn.silu(c_ctx) @ w_ada[layer] + b_ada[layer]
        sh1_l, sc1_l, g1_l, sh2_l, sc2_l, g2_l = jnp.split(mod_l, 6, axis=-1)
        sh1_c, sc1_c, g1_c, sh2_c, sc2_c, g2_c = jnp.split(mod_c, 6, axis=-1)
        h_l = modulate(x_l, sh1_l, sc1_l)
        h_c = modulate(x_c, sh1_c, sc1_c)
        i = layer // 2
        if layer % 2 == 0:
            lam_init = 0.8 - 0.6 * math.exp(-0.3 * layer)
            y_l, y_c = even_mixer(h_l, h_c, w_in_e[i], w_out_e[i], na_q_gain[i], na_k_gain[i], na_rpb[i],
                                  da_q_gain[i], da_k_gain[i], da_lambda_q1[i], da_lambda_k1[i],
                                  da_lambda_q2[i], da_lambda_k2[i], da_subln_gain[i], lam_init, cos, sin,
                                  with_ctx)
        else:
            y_l, y_c = odd_mixer(h_l, h_c, w_in_o[i], w_out_o[i], gqa_q_gain[i], gqa_k_gain[i],
                                 hy_conv_w[i], hy_conv_b[i], hy_w1[i], hy_b1[i], hy_w2[i], hy_b2[i],
                                 hy_w3[i], hy_b3[i], hy_w4[i], hy_freq[i], hy_skip[i], cos, sin, with_ctx)
        x_l = x_l + g1_l * y_l
        x_l = x_l + g2_l * conv_ffn(modulate(x_l, sh2_l, sc2_l), w_up[layer], ffn_conv_w[layer],
                                    ffn_conv_b[layer], w_down[layer])
        if with_ctx:
            x_c = x_c + g1_c * y_c
            x_c = x_c + g2_c * conv_ffn(modulate(x_c, sh2_c, sc2_c), w_up[layer], ffn_conv_w[layer],
                                        ffn_conv_b[layer], w_down[layer])
    return x_l
```

```cpp
#include <hip/hip_runtime.h>
#include <hip/hip_cooperative_groups.h>
#include <hip/hip_bf16.h>
#include <cstdio>
#include <cstdint>
#include <cmath>
namespace cg = cooperative_groups;
__device__ __forceinline__ int lane_asm() { int x; asm volatile("v_mbcnt_lo_u32_b32 %0, -1, 0\n\tv_mbcnt_hi_u32_b32 %0, -1, %0" : "=v"(x)); return x; }
__device__ __forceinline__ float shfl_l(float v, int srclane) { return __builtin_bit_cast(float, __builtin_amdgcn_ds_bpermute(srclane << 2, __builtin_bit_cast(int, v))); }
namespace pg8 {
#define PG8_LAS __attribute__((address_space(3)))
typedef unsigned short bf16_t;
typedef short bf16x8 __attribute__((ext_vector_type(8)));
typedef float f32x4 __attribute__((ext_vector_type(4)));
typedef unsigned u32x4 __attribute__((ext_vector_type(4)));
constexpr int BM = 256, BK = 64, HALF = 128, HTB = HALF * BK * 2  , STAGE_BYTES = 8 * HTB, NXCD = 8, WGM = 8;

__host__ __device__ __forceinline__ int lds_byte(int r, int c) { const int st = (r >> 4) * 2 + (c >> 5), rr = r & 15, cc = c & 31, ob = rr * 64 + cc * 2; return st * 1024 + (ob ^ (((ob >> 9) & 1) << 5)); }
__host__ __device__ __forceinline__ void stage_rc(int b, int& R, int& C) { const int st = b / 1024, sb = b % 1024, swz = sb ^ (((sb >> 9) & 1) << 5); R = (st >> 1) * 16 + swz / 64; C = (st & 1) * 32 + (swz % 64) / 2; }
__host__ __device__ __forceinline__ int perm32(int rho) { const int n = rho >> 4, i = rho & 15; return 8 * (i >> 2) + 4 * n + (i & 3); }

struct Unit { int pm, pn; };
struct Gemm { const bf16_t* A; int lda; const bf16_t* Bt; int M, N, K; int ov = 0; };

struct StaticOrder {
    int nM, nN, nwg, G, c, skip;
    __host__ __device__ void init(int M, int N, int G_, int c_, int skip_ = 0) { nM = skip_ ? 128 : M / BM; nN = N / BM; nwg = nM * nN; G = G_; c = c_; skip = skip_; }
    __host__ __device__ bool next(int i, Unit& u) const {
        const long L = (long)i * G + c; if (L >= nwg) return false;
        int wgid = (int)L; { const int q = nwg / NXCD, r = nwg % NXCD, xcd = wgid % NXCD, off = wgid / NXCD; wgid = (xcd < r ? xcd * (q + 1) : r * (q + 1) + (xcd - r) * q) + off; }
        const int nig = WGM * nN, gid = wgid / nig, fm = gid * WGM, gsz = (nM - fm) < WGM ? (nM - fm) : WGM;
        u.pm = fm + ((wgid % nig) % gsz); u.pn = (wgid % nig) / gsz; if (skip) u.pm += u.pm >> 5; return true;
    }
    __device__ __forceinline__ void a_ready(const Unit&) const {}
    __device__ __forceinline__ void done(const Unit&) const {}
};

__device__ __forceinline__ unsigned cvt_pk_bf16(float lo, float hi) { unsigned r; asm volatile("v_cvt_pk_bf16_f32 %0, %1, %2" : "=v"(r) : "v"(lo), "v"(hi)); return r; }
typedef float f32x2 __attribute__((ext_vector_type(2)));
__device__ __forceinline__ f32x2 gelu_pk(f32x2 v) {
    const f32x2 av = __builtin_elementwise_abs(v), d = av * 0.2316418882f + 1.0f;
    f32x2 t; t.x = __builtin_amdgcn_rcpf(d.x); t.y = __builtin_amdgcn_rcpf(d.y);
    f32x2 q = t * 0.5307027145f + (-0.7265760135f); q = q * t + 0.7107068705f; q = q * t + (-0.142248368f); q = q * t + 0.127414796f; q = q * t;
    const f32x2 s = (v * v) * (-0.72134752044f);
    f32x2 e; e.x = __builtin_amdgcn_exp2f(s.x); e.y = __builtin_amdgcn_exp2f(s.y);
    const f32x2 m = v * (q * e), r = v - m;
    f32x2 o; o.x = v.x < 0.f ? m.x : r.x; o.y = v.y < 0.f ? m.y : r.y; return o;
}

template <int ACT  > struct EpiBf16 {
    static constexpr bool PERM = true, AFTER_DRAIN = false; static_assert(ACT == 0 || ACT == 1, "EpiBf16: ACT is 0 (none) or 1 (gelu_pk)");
    bf16_t* O; int ldc; const float* bias; int split_cols; size_t split_stride; float scale0;
    __device__ __forceinline__ void operator()(const f32x4 (&acc)[2][2][4][2], const Unit& u, int wr, int wc, int fr, int fq) const {
        const int row0 = u.pm * BM + wr * 64 + fr; int colt = u.pn * BM; bf16_t* base = O;
        float sc = 1.f; if (split_cols) { const int t = colt / split_cols; base += (size_t)t * split_stride; colt -= t * split_cols; if (t == 0) sc = scale0; }
        const int col0 = colt + wc * 32 + 8 * fq, bcol0 = u.pn * BM + wc * 32 + 8 * fq;
        f32x4 bv[2][2];
#pragma unroll
        for (int bj = 0; bj < 2; ++bj)
#pragma unroll
            for (int n = 0; n < 2; ++n) bv[bj][n] = bias ? *(const f32x4*)(bias + bcol0 + bj * HALF + 4 * n) : (f32x4){0.f, 0.f, 0.f, 0.f};
#pragma unroll
        for (int ai = 0; ai < 2; ++ai)
#pragma unroll
            for (int m = 0; m < 4; ++m) { bf16_t* rowp = base + (size_t)(row0 + ai * HALF + m * 16) * ldc + col0;
#pragma unroll
                for (int bj = 0; bj < 2; ++bj) { f32x4 v0 = acc[ai][bj][m][0] + bv[bj][0], v1 = acc[ai][bj][m][1] + bv[bj][1];
                    if (ACT == 1) { f32x2 a = gelu_pk((f32x2){v0[0], v0[1]}), b = gelu_pk((f32x2){v0[2], v0[3]}), c = gelu_pk((f32x2){v1[0], v1[1]}), d = gelu_pk((f32x2){v1[2], v1[3]});
                        v0 = (f32x4){a.x, a.y, b.x, b.y}; v1 = (f32x4){c.x, c.y, d.x, d.y}; }
                    v0 = v0 * sc; v1 = v1 * sc; u32x4 w; w.x = cvt_pk_bf16(v0[0], v0[1]); w.y = cvt_pk_bf16(v0[2], v0[3]); w.z = cvt_pk_bf16(v1[0], v1[1]); w.w = cvt_pk_bf16(v1[2], v1[3]);
                    *(u32x4*)(rowp + bj * HALF) = w; } }
    }
};
template <class Epi, class Sched, bool ALIGN_EPI = false, bool SP2 = false>
__device__ __forceinline__ void gemm_phase(PG8_LAS unsigned char* lds, const Gemm g, const Sched& S, const Epi& E, int wave0) {
    int tid_ = wave0 * 64 + lane_asm(); asm volatile("" : "+v"(tid_)); const int tid = tid_, wid = __builtin_amdgcn_readfirstlane(tid >> 6), lane = tid & 63, wr = wid >> 2, wc = wid & 3, fr = lane & 15, fq = lane >> 4;
    const int K = g.K, nt = K / BK;
    unsigned voffA[2], voffB[2];
#pragma unroll
    for (int i = 0; i < 2; ++i) { int R, C; stage_rc(tid * 16 + i * 8192, R, C); const int Rb = Epi::PERM ? ((R & ~31) + perm32(R & 31)) : R;
        voffA[i] = (unsigned)((g.ov ? R - 2 * (R >> 6) : R) * g.lda + C) * 2u; voffB[i] = (unsigned)(Rb * K + C) * 2u; }
    const size_t kstep = (size_t)(BK * 2);
    const size_t hstepA = (size_t)(g.ov ? 124 : HALF) * g.lda * 2, hstepB = (size_t)HALF * K * 2;
    const size_t tstepA = 2 * hstepA, tstepB = 2 * hstepB;
    const unsigned ldsw = (unsigned)wid * 1024u;
    const int aoff = lds_byte(wr * 64 + fr, fq * 8), boff = lds_byte(wc * 32 + fr, fq * 8);
#define PG8_SA(b, h) (((b) * 2 + (h)) * HTB)
#define PG8_SB(b, h) ((4 + (b) * 2 + (h)) * HTB)
#define PG8_STAGE(bufoff, gbase, voff) do { _Pragma("unroll") for (int _i = 0; _i < 2; ++_i) \
        __builtin_amdgcn_global_load_lds((const unsigned*)((const char*)(gbase) + (voff)[_i]), (PG8_LAS unsigned*)(lds + (bufoff) + ldsw + _i * 8192), 16, 0, 0); } while (0)
#define PG8_LDA(dst, b, h) do { _Pragma("unroll") for (int m = 0; m < 4; ++m) _Pragma("unroll") for (int k = 0; k < 2; ++k) dst[m][k] = *(const PG8_LAS bf16x8*)(lds + PG8_SA(b, h) + aoff + m * 2048 + k * 1024); } while (0)
#define PG8_LDB(dst, b, h) do { _Pragma("unroll") for (int n = 0; n < 2; ++n) _Pragma("unroll") for (int k = 0; k < 2; ++k) dst[n][k] = *(const PG8_LAS bf16x8*)(lds + PG8_SB(b, h) + boff + n * 2048 + k * 1024); } while (0)
#define PG8_MMA(ai, bj, At, Bt) do { __builtin_amdgcn_s_setprio(1); _Pragma("unroll") for (int m = 0; m < 4; ++m) _Pragma("unroll") for (int n = 0; n < 2; ++n) _Pragma("unroll") for (int k = 0; k < 2; ++k) \
        acc[ai][bj][m][n] = __builtin_amdgcn_mfma_f32_16x16x32_bf16(Bt[n][k], At[m][k], acc[ai][bj][m][n], 0, 0, 0); __builtin_amdgcn_s_setprio(0); } while (0)
#define PG8_WAIT_V(n) asm volatile("s_waitcnt vmcnt(" #n ")" ::: "memory")
#define PG8_WAIT_L(n) asm volatile("s_waitcnt lgkmcnt(" #n ")" ::: "memory")
#define PG8_BAR __builtin_amdgcn_s_barrier()
#define PG8_SCHED __builtin_amdgcn_sched_barrier(0)
    Unit cur, nxt; int ui = 0;
    if (!S.next(0, cur)) return;
    f32x4 acc[2][2][4][2];
#pragma unroll
    for (int a = 0; a < 2; ++a)
#pragma unroll
        for (int b = 0; b < 2; ++b)
#pragma unroll
            for (int m = 0; m < 4; ++m)
#pragma unroll
                for (int n = 0; n < 2; ++n) acc[a][b][m][n] = (f32x4){0.f, 0.f, 0.f, 0.f};
    bf16x8 At[4][2], B0[2][2], B1[2][2];
    const char* cA = (const char*)g.A + (size_t)cur.pm * tstepA; const char* cB = (const char*)g.Bt + (size_t)cur.pn * tstepB;
    S.a_ready(cur);
    if constexpr (SP2) {
        PG8_STAGE(PG8_SB(0, 0), cB, voffB); PG8_STAGE(PG8_SB(0, 1), cB + hstepB, voffB); PG8_STAGE(PG8_SA(0, 0), cA, voffA); PG8_STAGE(PG8_SA(0, 1), cA + hstepA, voffA);
        if (wr == 1) PG8_BAR;
        PG8_WAIT_V(2); PG8_BAR;
        PG8_STAGE(PG8_SB(1, 0), cB + kstep, voffB); PG8_STAGE(PG8_SA(1, 0), cA + kstep, voffA); PG8_STAGE(PG8_SB(1, 1), cB + hstepB + kstep, voffB);
        PG8_WAIT_V(6); PG8_BAR;
    } else {
        PG8_STAGE(PG8_SB(0, 0), cB, voffB); PG8_STAGE(PG8_SA(0, 0), cA, voffA); PG8_STAGE(PG8_SB(0, 1), cB + hstepB, voffB); PG8_STAGE(PG8_SA(0, 1), cA + hstepA, voffA);
        if (wr == 1) PG8_BAR;
        PG8_WAIT_V(4); PG8_BAR;
        PG8_STAGE(PG8_SB(1, 0), cB + kstep, voffB); PG8_STAGE(PG8_SA(1, 0), cA + kstep, voffA); PG8_STAGE(PG8_SB(1, 1), cB + hstepB + kstep, voffB);
        PG8_WAIT_V(6); PG8_BAR;
    }
    for (;;) {
        const bool has_next = S.next(ui + 1, nxt);
        const char* nA = has_next ? (const char*)g.A + (size_t)nxt.pm * tstepA : cA; const char* nB = has_next ? (const char*)g.Bt + (size_t)nxt.pn * tstepB : cB;
        for (int t = 0; t < nt; t += 2) {
            const bool last = (t == nt - 2);
            const char* a1 = cA + (size_t)(t + 1) * kstep;
            const char* a2 = last ? nA : cA + (size_t)(t + 2) * kstep; const char* b2 = last ? nB : cB + (size_t)(t + 2) * kstep;
            const char* a3 = a2 + kstep; const char* b3 = b2 + kstep;
            if (last && has_next) S.a_ready(nxt);
            if constexpr (SP2) {
            PG8_LDB(B0, 0, 0); PG8_LDB(B1, 0, 1); PG8_SCHED; PG8_LDA(At, 0, 0); PG8_STAGE(PG8_SA(1, 1), a1 + hstepA, voffA);
            PG8_WAIT_V(8); PG8_WAIT_L(0); PG8_BAR; PG8_MMA(0, 0, At, B0); PG8_MMA(0, 1, At, B1); PG8_BAR; PG8_SCHED;
            PG8_LDA(At, 0, 1); PG8_STAGE(PG8_SB(0, 0), b2, voffB); PG8_STAGE(PG8_SB(0, 1), b2 + hstepB, voffB); PG8_STAGE(PG8_SA(0, 0), a2, voffA);
            PG8_WAIT_V(8); PG8_WAIT_L(0); PG8_BAR; PG8_MMA(1, 0, At, B0); PG8_MMA(1, 1, At, B1); PG8_BAR; PG8_SCHED;
            PG8_LDB(B0, 1, 0); PG8_LDB(B1, 1, 1); PG8_SCHED; PG8_LDA(At, 1, 0); PG8_STAGE(PG8_SA(0, 1), a2 + hstepA, voffA);
            PG8_WAIT_V(8); PG8_WAIT_L(0); PG8_BAR; PG8_MMA(0, 0, At, B0); PG8_MMA(0, 1, At, B1); PG8_BAR; PG8_SCHED;
            PG8_LDA(At, 1, 1); PG8_STAGE(PG8_SB(1, 0), b3, voffB); PG8_STAGE(PG8_SB(1, 1), b3 + hstepB, voffB); PG8_STAGE(PG8_SA(1, 0), a3, voffA);
            PG8_WAIT_V(8); PG8_WAIT_L(0); PG8_BAR; PG8_MMA(1, 0, At, B0); PG8_MMA(1, 1, At, B1); PG8_BAR; PG8_SCHED;
            } else {
            PG8_LDB(B0, 0, 0); PG8_SCHED; PG8_LDA(At, 0, 0); PG8_STAGE(PG8_SA(1, 1), a1 + hstepA, voffA);
            PG8_WAIT_L(8); PG8_BAR; PG8_WAIT_L(0); PG8_MMA(0, 0, At, B0); PG8_BAR; PG8_SCHED;
            PG8_LDB(B1, 0, 1); PG8_STAGE(PG8_SB(0, 0), b2, voffB);
            PG8_BAR; PG8_WAIT_L(0); PG8_MMA(0, 1, At, B1); PG8_BAR;
            PG8_LDA(At, 0, 1); PG8_STAGE(PG8_SA(0, 0), a2, voffA);
            PG8_BAR; PG8_WAIT_L(0); PG8_MMA(1, 0, At, B0); PG8_BAR; PG8_SCHED;
            PG8_STAGE(PG8_SB(0, 1), b2 + hstepB, voffB);
            PG8_WAIT_V(6); PG8_BAR; PG8_MMA(1, 1, At, B1); PG8_BAR;
            PG8_LDB(B0, 1, 0); PG8_SCHED; PG8_LDA(At, 1, 0); PG8_STAGE(PG8_SA(0, 1), a2 + hstepA, voffA);
            PG8_WAIT_L(8); PG8_BAR; PG8_WAIT_L(0); PG8_MMA(0, 0, At, B0); PG8_BAR; PG8_SCHED;
            PG8_LDB(B1, 1, 1); PG8_STAGE(PG8_SB(1, 0), b3, voffB);
            PG8_BAR; PG8_WAIT_L(0); PG8_MMA(0, 1, At, B1); PG8_BAR;
            PG8_LDA(At, 1, 1); PG8_STAGE(PG8_SA(1, 0), a3, voffA);
            PG8_BAR; PG8_WAIT_L(0); PG8_MMA(1, 0, At, B0); PG8_BAR; PG8_SCHED;
            PG8_STAGE(PG8_SB(1, 1), b3 + hstepB, voffB);
            PG8_WAIT_V(6); PG8_BAR; PG8_MMA(1, 1, At, B1); PG8_BAR;
            }
        }
        if constexpr (ALIGN_EPI) { if (wr == 0) PG8_BAR; }
        if constexpr (!Epi::AFTER_DRAIN) { E(acc, cur, wr, wc, fr, fq); S.done(cur); }
        if (!has_next) break;
#pragma unroll
        for (int a = 0; a < 2; ++a)
#pragma unroll
            for (int b = 0; b < 2; ++b)
#pragma unroll
                for (int m = 0; m < 4; ++m)
#pragma unroll
                    for (int n = 0; n < 2; ++n) acc[a][b][m][n] = (f32x4){0.f, 0.f, 0.f, 0.f};
        cur = nxt; cA = nA; cB = nB; ++ui;
        if constexpr (ALIGN_EPI) { if (wr == 1) PG8_BAR; }
    }
    PG8_WAIT_V(0);
    if constexpr (!ALIGN_EPI) { if (wr == 0) PG8_BAR; }
    PG8_BAR;
    if constexpr (Epi::AFTER_DRAIN) { E.fused(acc, cur, wr, wc, fr, fq, lds, wid, lane); S.done(cur); }
#undef PG8_SA
#undef PG8_SB
#undef PG8_STAGE
#undef PG8_LDA
#undef PG8_LDB
#undef PG8_MMA
#undef PG8_WAIT_V
#undef PG8_WAIT_L
#undef PG8_BAR
#undef PG8_SCHED
}
}
#include <hip/hip_bf16.h>
namespace attn_body {
using bf16=__hip_bfloat16;
using bf16x8=__attribute__((ext_vector_type(8)))short;
using s16x4=__attribute__((ext_vector_type(4)))short;
using f32x16=__attribute__((ext_vector_type(16)))float;
using u32x4=__attribute__((ext_vector_type(4)))unsigned;
constexpr int D=64;
constexpr int NW=8,QBLK=32,QB=QBLK*NW,KVBLK=64;
__device__ __forceinline__ int crow(int r,int hi){return (r&3)+8*(r>>2)+4*hi;}
#define SBAR() __builtin_amdgcn_sched_barrier(0)
constexpr int NSLOT=3, SLOTB=8192;
constexpr int LDS_K=0, LDS_V=NSLOT*SLOTB, LDS_WS=2*NSLOT*SLOTB, LDS_OST=LDS_WS+NW*64*4, LDS_BYTES=LDS_OST+NW*4096;
constexpr float C2=0.125f*1.4426950408889634f;
__device__ __forceinline__ void glds16(const void*gsrc,unsigned lds_dst){unsigned keep;
  asm volatile("s_mov_b32 %0, m0\n\ts_mov_b32 m0, %2\n\ts_nop 0\n\tglobal_load_lds_dwordx4 %1, off\n\ts_mov_b32 m0, %0":"=&s"(keep):"v"(gsrc),"s"(lds_dst):"memory");}
__device__ __forceinline__ float max3f(float a,float b,float c){float r;asm("v_max3_f32 %0, %1, %2, %3":"=v"(r):"v"(a),"v"(b),"v"(c));return r;}
__device__ __forceinline__ float max2f(float a,float b){float r;asm("v_max_f32_e32 %0, %1, %2":"=v"(r):"v"(a),"v"(b));return r;}
__device__ __forceinline__ float fadd_s(float a,float b){float r;asm("v_add_f32_e32 %0, %1, %2":"=v"(r):"v"(a),"v"(b));return r;}
__device__ __forceinline__ float fsub_s(float a,float b){float r;asm("v_sub_f32_e32 %0, %1, %2":"=v"(r):"v"(a),"v"(b));return r;}
typedef float f32x2_t __attribute__((ext_vector_type(2))); typedef __bf16 bf16x2_t __attribute__((ext_vector_type(2)));
__device__ __forceinline__ unsigned cvtpk_s(float lo,float hi){f32x2_t v={lo,hi};bf16x2_t b=__builtin_convertvector(v,bf16x2_t);return __builtin_bit_cast(unsigned,b);}
#define WAIT_BAR(N) asm volatile("s_waitcnt vmcnt(" #N ") lgkmcnt(0)\n\ts_barrier":::"memory")

__device__ __forceinline__ void qkt(f32x16&p0,f32x16&p1,const char*Kslot,const bf16x8*qr,const f32x16&negm,int r32,int hi){
  const char*kb=Kslot+hi*1024+r32*16;
  #pragma unroll
  for(int d0=0;d0<4;++d0){
    const bf16x8 b0=*reinterpret_cast<const bf16x8*>(kb+d0*2048);
    const bf16x8 b1=*reinterpret_cast<const bf16x8*>(kb+d0*2048+512);
    if(d0==0){p0=__builtin_amdgcn_mfma_f32_32x32x16_bf16(b0,qr[0],negm,0,0,0);p1=__builtin_amdgcn_mfma_f32_32x32x16_bf16(b1,qr[0],negm,0,0,0);}
    else{p0=__builtin_amdgcn_mfma_f32_32x32x16_bf16(b0,qr[d0],p0,0,0,0);p1=__builtin_amdgcn_mfma_f32_32x32x16_bf16(b1,qr[d0],p1,0,0,0);}}
}
typedef __attribute__((address_space(3))) const char* lds_cptr;
typedef short v4i16_t __attribute__((ext_vector_type(4)));
__device__ __forceinline__ void kload8(bf16x8*kf,lds_cptr kp){
  kf[0]=*(const __attribute__((address_space(3))) bf16x8*)(kp);      kf[1]=*(const __attribute__((address_space(3))) bf16x8*)(kp+512);
  kf[2]=*(const __attribute__((address_space(3))) bf16x8*)(kp+2048); kf[3]=*(const __attribute__((address_space(3))) bf16x8*)(kp+2560);
  kf[4]=*(const __attribute__((address_space(3))) bf16x8*)(kp+4096); kf[5]=*(const __attribute__((address_space(3))) bf16x8*)(kp+4608);
  kf[6]=*(const __attribute__((address_space(3))) bf16x8*)(kp+6144); kf[7]=*(const __attribute__((address_space(3))) bf16x8*)(kp+6656);
}
__device__ __forceinline__ void kload2(bf16x8*kf,lds_cptr kp,int j){ kf[2*j]=*(const __attribute__((address_space(3))) bf16x8*)(kp+j*2048); kf[2*j+1]=*(const __attribute__((address_space(3))) bf16x8*)(kp+j*2048+512); }
__device__ __forceinline__ s16x4 vtr(lds_cptr p){ return __builtin_bit_cast(s16x4,__builtin_amdgcn_ds_read_tr16_b64_v4i16((__attribute__((address_space(3))) v4i16_t*)p)); }
__device__ __forceinline__ float rowmax(const f32x16&p0,const f32x16&p1){
  float a=max3f(p0[0],p0[1],p1[0]),b=max3f(p0[2],p0[3],p1[1]);a=max3f(a,p1[2],p1[3]);
  #pragma unroll
  for(int r=4;r<16;r+=4){a=max3f(a,p0[r],p0[r+1]);b=max3f(b,p0[r+2],p0[r+3]);a=max3f(a,p1[r],p1[r+1]);b=max3f(b,p1[r+2],p1[r+3]);}
  const float m=max2f(a,b);
  auto rr=__builtin_amdgcn_permlane32_swap(__float_as_uint(m),__float_as_uint(m),false,false);
  return max2f(__uint_as_float(rr[0]),__uint_as_float(rr[1]));
}
__device__ __forceinline__ void pv(f32x16*o,int vb,bf16x8 pa0,bf16x8 pa1,bf16x8 pa2,bf16x8 pa3){
  #pragma unroll
  for(int d0=0;d0<2;++d0){s16x4 lo[4],hi[4];
    #pragma unroll
    for(int ks=0;ks<4;++ks){
      asm volatile("ds_read_b64_tr_b16 %0,%1 offset:%c2":"=&v"(lo[ks]):"v"(vb),"i"(d0*4096+ks*1024):"memory");
      asm volatile("ds_read_b64_tr_b16 %0,%1 offset:%c2":"=&v"(hi[ks]):"v"(vb),"i"(d0*4096+ks*1024+512):"memory");}
    asm volatile("s_waitcnt lgkmcnt(0)":::"memory");SBAR();
    #define PK(k) (bf16x8){lo[k][0],lo[k][1],lo[k][2],lo[k][3],hi[k][0],hi[k][1],hi[k][2],hi[k][3]}
    o[d0]=__builtin_amdgcn_mfma_f32_32x32x16_bf16(pa0,PK(0),o[d0],0,0,0);
    o[d0]=__builtin_amdgcn_mfma_f32_32x32x16_bf16(pa1,PK(1),o[d0],0,0,0);
    o[d0]=__builtin_amdgcn_mfma_f32_32x32x16_bf16(pa2,PK(2),o[d0],0,0,0);
    o[d0]=__builtin_amdgcn_mfma_f32_32x32x16_bf16(pa3,PK(3),o[d0],0,0,0);
    #undef PK
  }
}

#ifndef ATTN_STORE16
#define ATTN_STORE16(p,v) (*(u32x4*)(p)=(v))
#endif
template<int THRL,class TM> __device__ __forceinline__ void attn_unit(const bf16*Q,int ptq,const bf16*__restrict__ K,int ptk,const bf16*__restrict__ V,int ptv,bf16*O,int pto,int NT,const TM tm,char*shm,int wave0){
  int tid_=wave0*64+lane_asm(); asm volatile("":"+v"(tid_)); const int tid=tid_,lane=tid&63,r32=lane&31,hi=lane>>5; const int wid=__builtin_amdgcn_readfirstlane(tid>>6);
  const bf16*Qw=Q+(long)(wid*QBLK)*ptq;
  const bf16*Kh=K,*Vh=V;
  const unsigned lds0=(unsigned)(uintptr_t)shm;
  float*wsf=(float*)(shm+LDS_WS)+wid*64;
  const bf16*ksrc=Kh+(long)lane*ptk+wid*8;
  const bf16*vsrc=Vh+(long)(16*(wid&3)+(lane>>2))*ptv+(wid>>2)*32+(lane&3)*8;
  const unsigned kdst=lds0+LDS_K+wid*1024, vdst=lds0+LDS_V+wid*1024;
  #define DMA_K(t,slot) glds16(ksrc+(long)tm.row(t)*ptk,(unsigned)__builtin_amdgcn_readfirstlane(kdst+(slot)))
  #define DMA_V(t,slot) glds16(vsrc+(long)tm.row(t)*ptv,(unsigned)__builtin_amdgcn_readfirstlane(vdst+(slot)))
  const int vb0=(int)(lds0+LDS_V)+((lane>>4)&1)*32+(lane&3)*8+(4*hi+((lane&15)>>2))*64;
  const char*Kbase=shm+LDS_K; bf16x8 kf[8];
  const lds_cptr shm3=(lds_cptr)shm; const lds_cptr kp0=shm3+LDS_K+hi*1024+r32*16; const lds_cptr vp0=shm3+LDS_V+((lane>>4)&1)*32+(lane&3)*8+(4*hi+((lane&15)>>2))*64;
  DMA_K(0,0);DMA_V(0,0);DMA_K(1,SLOTB);
  bf16x8 qr[4];
  #pragma unroll
  for(int d0=0;d0<4;++d0)qr[d0]=*reinterpret_cast<const bf16x8*>(&Qw[(long)r32*ptq+d0*16+hi*8]);
  float mhat=0.f,l_reg=0.f;f32x16 o[2];o[0]=f32x16{};o[1]=f32x16{};f32x16 negm=f32x16{};asm volatile("":"+v"(negm));
  const int qrel=wid*QBLK+r32;
  #define CMASK(P0,P1,t) do{ if(TM::HAS_MASK) tm.mask(P0,P1,(t),qrel,hi); }while(0)
  bool resc=false;
  #define START(P0,P1) do{ const float rm=rowmax(P0,P1); resc=false; \
    { const float dl=rm; mhat=fadd_s(mhat,dl); \
      _Pragma("unroll") for(int r=0;r<16;++r){P0[r]=fsub_s(P0[r],dl);P1[r]=fsub_s(P1[r],dl);} \
      _Pragma("unroll") for(int r=0;r<16;++r)negm[r]=-mhat; asm volatile("":"+v"(negm)); } \
    _Pragma("unroll") for(int r=0;r<16;++r)P0[r]=__builtin_amdgcn_exp2f(P0[r]); }while(0)
  #define RESC() do{ if(resc){ asm volatile("s_waitcnt lgkmcnt(0)":::"memory"); \
      _Pragma("unroll") for(int d_=0;d_<2;++d_) _Pragma("unroll") for(int r=0;r<16;++r)o[d_][r]*=wsf[crow(r,hi)]; } }while(0)
  f32x16 pA0,pA1,pB0,pB1;
  int sl_prev=0,sl_cur=0,sl_next=SLOTB;
  #define ROT() do{sl_prev=sl_cur;sl_cur=sl_next;sl_next=(sl_next==(NSLOT-1)*SLOTB)?0:sl_next+SLOTB;}while(0)
  DMA_K(2,2*SLOTB);
  WAIT_BAR(3);
  qkt(pA0,pA1,Kbase,qr,negm,r32,hi);asm volatile("s_nop 15\n\ts_nop 7":"+v"(pA0),"+v"(pA1));
  START(pA0,pA1);
  _Pragma("unroll") for(int r=0;r<16;++r)pA1[r]=__builtin_amdgcn_exp2f(pA1[r]);
  WAIT_BAR(0);
  DMA_K(3,0);DMA_V(1,SLOTB);
  ROT();
  kload8(kf,kp0+sl_cur);
  WAIT_BAR(2);
  s16x4 vlo[8],vhi[8]; u32x4 pw0,pw1,pw2,pw3;
  #define PKW(P,B) cvtpk_s(P[B],P[B+1])
  #define PAF(k) __builtin_bit_cast(bf16x8,pw##k)
  #define VFR(i) (bf16x8){vlo[i][0],vlo[i][1],vlo[i][2],vlo[i][3],vhi[i][0],vhi[i][1],vhi[i][2],vhi[i][3]}
  #define PIN(x) asm volatile("":"+v"(x))
  #define MX3(a,b,c) __builtin_fmaxf(__builtin_fmaxf((a),(b)),(c))
  #define GAPA(MF,A0,A1,A2,A3,W0,W1,PW) do{ MF; sacc+=A0; sacc+=A1; sacc+=A2; sacc+=A3; PIN(sacc); W0; W1; PIN(PW); SBAR(); }while(0)
  #define EX(v) __builtin_amdgcn_exp2f(v)
  #define GAPB(MF,X,B) do{ MF; X[B]=EX(X[B]); X[B+1]=EX(X[B+1]); X[B+2]=EX(X[B+2]); X[B+3]=EX(X[B+3]); PIN(X); SBAR(); }while(0)
  #define VRD(i) do{ vlo[i]=vtr(vp_+(((i)>>2)*4096+((i)&3)*1024)); vhi[i]=vtr(vp_+(((i)>>2)*4096+((i)&3)*1024+512)); }while(0)
  #define KRD(G,j) do{ if(G){ kload2(kf,kp0+sl_next,j); SBAR(); } }while(0)
  #define STEP(C0,C1,P0,P1,t,GK,GV,GL) do{ SBAR(); \
    const lds_cptr vp_=vp0+sl_prev; \
    VRD(0); SBAR(); float sacc=(P0[0]+P0[1]); \
    GAPA(C0=__builtin_amdgcn_mfma_f32_32x32x16_bf16(kf[0],qr[0],negm,0,0,0), P0[2],P0[3],P0[4],P0[5],     pw0[0]=PKW(P0,0), pw0[1]=PKW(P0,2), pw0); \
    VRD(4); SBAR(); GAPA(C1=__builtin_amdgcn_mfma_f32_32x32x16_bf16(kf[1],qr[0],negm,0,0,0), P0[6],P0[7],P0[8],P0[9],     pw0[2]=PKW(P0,4), pw0[3]=PKW(P0,6), pw0); \
    VRD(1); SBAR(); GAPA(C0=__builtin_amdgcn_mfma_f32_32x32x16_bf16(kf[2],qr[1],C0,0,0,0),   P0[10],P0[11],P0[12],P0[13], pw1[0]=PKW(P0,8), pw1[1]=PKW(P0,10), pw1); \
    VRD(5); SBAR(); GAPA(C1=__builtin_amdgcn_mfma_f32_32x32x16_bf16(kf[3],qr[1],C1,0,0,0),   P0[14],P0[15],P1[0],P1[1],   pw1[2]=PKW(P0,12),pw1[3]=PKW(P0,14), pw1); \
    VRD(2); SBAR(); GAPA(C0=__builtin_amdgcn_mfma_f32_32x32x16_bf16(kf[4],qr[2],C0,0,0,0),   P1[2],P1[3],P1[4],P1[5],     pw2[0]=PKW(P1,0), pw2[1]=PKW(P1,2), pw2); \
    VRD(6); SBAR(); GAPA(C1=__builtin_amdgcn_mfma_f32_32x32x16_bf16(kf[5],qr[2],C1,0,0,0),   P1[6],P1[7],P1[8],P1[9],     pw2[2]=PKW(P1,4), pw2[3]=PKW(P1,6), pw2); \
    VRD(3); SBAR(); GAPA(C0=__builtin_amdgcn_mfma_f32_32x32x16_bf16(kf[6],qr[3],C0,0,0,0),   P1[10],P1[11],P1[12],P1[13], pw3[0]=PKW(P1,8), pw3[1]=PKW(P1,10), pw3); \
    VRD(7); SBAR(); GAPA(C1=__builtin_amdgcn_mfma_f32_32x32x16_bf16(kf[7],qr[3],C1,0,0,0),   P1[14],P1[15],0.f,0.f,       pw3[2]=PKW(P1,12),pw3[3]=PKW(P1,14), pw3); \
    l_reg+=sacc; \
    if(GK){DMA_K((t)+3,sl_cur);} if(GV){DMA_V((t)+1,sl_next);} \
    CMASK(C0,C1,t); \
    { float a=MX3(C0[0],C0[1],C1[0]),b=MX3(C0[2],C0[3],C1[1]); a=MX3(a,C1[2],C1[3]); \
      _Pragma("unroll") for(int r=4;r<16;r+=4){a=MX3(a,C0[r],C0[r+1]);b=MX3(b,C0[r+2],C0[r+3]);a=MX3(a,C1[r],C1[r+1]);b=MX3(b,C1[r+2],C1[r+3]);} \
      float rm=__builtin_fmaxf(a,b); { auto rr=__builtin_amdgcn_permlane32_swap(__float_as_uint(rm),__float_as_uint(rm),false,false); rm=__builtin_fmaxf(__uint_as_float(rr[0]),__uint_as_float(rr[1])); } \
      resc=false; \
      if(__builtin_expect(__any(rm>(float)THRL),0)){ const float dl=__builtin_fmaxf(rm,0.f); mhat+=dl; \
        _Pragma("unroll") for(int r=0;r<16;++r){C0[r]-=dl;C1[r]-=dl;} \
        _Pragma("unroll") for(int r=0;r<16;++r)negm[r]=-mhat; asm volatile("":"+v"(negm)); \
        const float f=__builtin_amdgcn_exp2f(-dl); l_reg*=f; if(hi==0)wsf[r32]=f; resc=true; } } \
    SBAR(); \
    GAPB(o[0]=__builtin_amdgcn_mfma_f32_32x32x16_bf16(PAF(0),VFR(0),o[0],0,0,0), C0,0); \
    GAPB(o[1]=__builtin_amdgcn_mfma_f32_32x32x16_bf16(PAF(0),VFR(4),o[1],0,0,0), C0,4); \
    KRD(GL,0); GAPB(o[0]=__builtin_amdgcn_mfma_f32_32x32x16_bf16(PAF(1),VFR(1),o[0],0,0,0), C0,8); \
    KRD(GL,1); GAPB(o[1]=__builtin_amdgcn_mfma_f32_32x32x16_bf16(PAF(1),VFR(5),o[1],0,0,0), C0,12); \
    KRD(GL,2); GAPB(o[0]=__builtin_amdgcn_mfma_f32_32x32x16_bf16(PAF(2),VFR(2),o[0],0,0,0), C1,0); \
    KRD(GL,3); GAPB(o[1]=__builtin_amdgcn_mfma_f32_32x32x16_bf16(PAF(2),VFR(6),o[1],0,0,0), C1,4); \
    GAPB(o[0]=__builtin_amdgcn_mfma_f32_32x32x16_bf16(PAF(3),VFR(3),o[0],0,0,0), C1,8); \
    GAPB(o[1]=__builtin_amdgcn_mfma_f32_32x32x16_bf16(PAF(3),VFR(7),o[1],0,0,0), C1,12); \
    }while(0)
  int t=1;
  for(;t+5<NT;t+=2){
    STEP(pB0,pB1,pA0,pA1,t,true,true,true);     WAIT_BAR(2); RESC(); ROT();
    STEP(pA0,pA1,pB0,pB1,t+1,true,true,true);   WAIT_BAR(2); RESC(); ROT();
  }
  #define ENDW(tt) do{ if((tt)+3<NT){WAIT_BAR(2);} else if((tt)+2<NT){WAIT_BAR(1);} else {WAIT_BAR(0);} }while(0)
  for(;t+1<NT;t+=2){
    STEP(pB0,pB1,pA0,pA1,t,(t+3<NT),(t+1<NT),(t+1<NT));       ENDW(t);   RESC(); ROT();
    STEP(pA0,pA1,pB0,pB1,t+1,(t+4<NT),(t+2<NT),(t+2<NT));     ENDW(t+1); RESC(); ROT();
  }
  STEP(pB0,pB1,pA0,pA1,NT-1,false,false,false); RESC();
  { float sacc=pB0[0]+pB0[1]; _Pragma("unroll") for(int r=2;r<16;++r)sacc+=pB0[r]; _Pragma("unroll") for(int r=0;r<16;++r)sacc+=pB1[r]; l_reg+=sacc;
    pw0=(u32x4){PKW(pB0,0),PKW(pB0,2),PKW(pB0,4),PKW(pB0,6)};pw1=(u32x4){PKW(pB0,8),PKW(pB0,10),PKW(pB0,12),PKW(pB0,14)};pw2=(u32x4){PKW(pB1,0),PKW(pB1,2),PKW(pB1,4),PKW(pB1,6)};pw3=(u32x4){PKW(pB1,8),PKW(pB1,10),PKW(pB1,12),PKW(pB1,14)};
    SBAR(); pv(o,vb0+sl_cur,PAF(0),PAF(1),PAF(2),PAF(3)); }
  #undef PKW
  #undef PAF
  #undef VFR
  #undef PIN
  #undef MX3
  #undef GAPA
  #undef GAPB
  #undef EX
  #undef VRD
  #undef KRD
  #undef STEP
  #undef ENDW
  {auto rr=__builtin_amdgcn_permlane32_swap(__float_as_uint(l_reg),__float_as_uint(l_reg),false,false);l_reg=__uint_as_float(rr[0])+__uint_as_float(rr[1]);}
  if(hi==0)wsf[32+r32]=l_reg;asm volatile("s_waitcnt lgkmcnt(0)":::"memory");
  float rli[16];
  #pragma unroll
  for(int r=0;r<16;++r)rli[r]=__builtin_amdgcn_rcpf(wsf[32+crow(r,hi)]);
  bf16*Ow=O+(long)(wid*QBLK)*pto;
  { bf16*stg=(bf16*)(shm+LDS_OST)+wid*2048;
    #pragma unroll
    for(int r=0;r<16;++r){const int orow=crow(r,hi);
      #pragma unroll
      for(int d0=0;d0<2;++d0)stg[orow*64+d0*32+r32]=__float2bfloat16(o[d0][r]*rli[r]);}
    asm volatile("s_waitcnt lgkmcnt(0)":::"memory");
    #pragma unroll
    for(int i=0;i<4;++i){const int row=i*8+(lane>>3),ch=lane&7; const u32x4 v=*(const u32x4*)(stg+row*64+ch*8); ATTN_STORE16(Ow+(long)row*pto+ch*8,v);} }
  asm volatile("s_waitcnt lgkmcnt(0)\n\ts_barrier":::"memory");
  #undef DMA_K
  #undef DMA_V
  #undef CMASK
  #undef START
  #undef RESC
  #undef ROT
}
constexpr int ATTN_LDS_BYTES=LDS_BYTES;
#undef SBAR
#undef WAIT_BAR
}
#define GAS __attribute__((address_space(1)))
#define LAS __attribute__((address_space(3)))
typedef unsigned short bf16;
typedef unsigned v4u __attribute__((ext_vector_type(4)));
typedef unsigned v2u __attribute__((ext_vector_type(2)));
typedef float f32x4 __attribute__((ext_vector_type(4)));
typedef float f32x16 __attribute__((ext_vector_type(16)));
typedef short bf16x8 __attribute__((ext_vector_type(8)));

constexpr int DMODEL = 1024, NBATCH = 4, SEQ = 8192, CTXL = 256, TPB = SEQ + CTXL, MROWS = NBATCH * TPB;
constexpr int FFH = 2816, NUP = 2 * FFH, NIN_E = 3072, NIN_O = 2304;
constexpr float EPS = 1e-6f;
constexpr float QSCALE = 0.125f * 1.4426950408889634f;
constexpr int NWAVES = 8, NTHREADS = 512;
constexpr int RING_BYTES = 131072, MISC_OFF = 139264, LDS_BYTES = 147456;

constexpr size_t MiB = (size_t)1 << 20;
constexpr size_t WS_CTL = 0, CTL_ZERO_BYTES = 64 * 1024;
constexpr size_t WS_MODS = 1 * MiB, WS_ROPE = 2 * MiB, WS_H3L = 4 * MiB, WS_H3C = 8 * MiB, WS_PART = 9 * MiB;
constexpr size_t WS_W = 10 * MiB, WS_WIN = WS_W, WS_WOUT = WS_W + 6 * MiB, WS_WUP = WS_W + 8 * MiB, WS_WDOWN = WS_W + 19 * MiB;
constexpr size_t WS_XC = 36 * MiB, WS_FILT = 40 * MiB, WS_FILTC = 72 * MiB, WS_YTC = 73 * MiB;
constexpr size_t WS_H = 74 * MiB, WS_U = 140 * MiB, WS_ZT = 338 * MiB, WS_X0T = 370 * MiB, WS_DAO = 338 * MiB, WS_GV = 140 * MiB;
constexpr size_t WS_END = 512 * MiB;
static_assert(WS_GV + (size_t)MROWS * NUP * 2 <= WS_END && WS_U + (size_t)MROWS * NIN_E * 2 <= WS_ZT && WS_DAO + (size_t)MROWS * 1024 * 2 <= WS_END, "ws map");
constexpr int CW_QUEUE = 1024;
constexpr int CW_BAR = 8192;

struct Args { const float* in[37]; float* out; unsigned char* ws; };
enum { I_X = 0, I_C, I_CTX, I_CCTX, I_WADA, I_BADA, I_WUP, I_FCW, I_FCB, I_WDOWN, I_WINE, I_WOUTE, I_NAQG, I_NAKG, I_RPB, I_DAQG, I_DAKG, I_LQ1, I_LK1, I_LQ2, I_LK2, I_SUBLN,
       I_WINO, I_WOUTO, I_GQG, I_GKG, I_HCW, I_HCB, I_HW1, I_HB1, I_HW2, I_HB2, I_HW3, I_HB3, I_HW4, I_HFREQ, I_HSKIP };

struct Frame { LAS unsigned char* lds; int tid, lane, wave, G, bid, wave0; };

__device__ __forceinline__ unsigned f2bf(float f) { unsigned u = __builtin_bit_cast(unsigned, f); return (u + 0x7fffu + ((u >> 16) & 1u)) >> 16; }
__device__ __forceinline__ unsigned pk2(float lo, float hi) { return f2bf(lo) | (f2bf(hi) << 16); }
__device__ __forceinline__ float bf2f(unsigned short h) { return __builtin_bit_cast(float, (unsigned)h << 16); }
__device__ __forceinline__ float bflo(unsigned w) { return __builtin_bit_cast(float, w << 16); }
__device__ __forceinline__ float bfhi(unsigned w) { return __builtin_bit_cast(float, w & 0xffff0000u); }
__device__ __forceinline__ float wave_sum(float v, int lane) {
#pragma unroll
    for (int o = 1; o < 64; o <<= 1) v += shfl_l(v, lane ^ o);
    return v;
}
#define LDS_WAIT() asm volatile("s_waitcnt lgkmcnt(0)" ::: "memory")

__device__ __forceinline__ const float* xrow_c(const float* xl, const float* xc, int row) { const int b = row / TPB, t = row - b * TPB; return t < SEQ ? xl + ((size_t)b * SEQ + t) * DMODEL : xc + ((size_t)b * CTXL + (t - SEQ)) * DMODEL; }
__device__ __forceinline__ float* xrow_m(float* xl, float* xc, int row) { const int b = row / TPB, t = row - b * TPB; return t < SEQ ? xl + ((size_t)b * SEQ + t) * DMODEL : xc + ((size_t)b * CTXL + (t - SEQ)) * DMODEL; }
__device__ __forceinline__ int modrow(int row) { const int b = row / TPB, t = row - b * TPB; return t < SEQ ? b : 4; }

struct EpiStore {
    static constexpr bool PERM = true, AFTER_DRAIN = false;
    bf16* O; int ldc;
    __device__ __forceinline__ void operator()(const pg8::f32x4 (&acc)[2][2][4][2], const pg8::Unit& u, int wr, int wc, int fr, int fq) const {
        const int row0 = u.pm * 256 + wr * 64 + fr, col0 = u.pn * 256 + wc * 32 + 8 * fq;
#pragma unroll
        for (int ai = 0; ai < 2; ++ai)
#pragma unroll
            for (int m = 0; m < 4; ++m) { bf16* rowp = O + (size_t)(row0 + ai * 128 + m * 16) * ldc + col0;
#pragma unroll
                for (int bj = 0; bj < 2; ++bj) { const pg8::f32x4 v0 = acc[ai][bj][m][0], v1 = acc[ai][bj][m][1];
                    v4u w; w.x = pg8::cvt_pk_bf16(v0[0], v0[1]); w.y = pg8::cvt_pk_bf16(v0[2], v0[3]); w.z = pg8::cvt_pk_bf16(v1[0], v1[1]); w.w = pg8::cvt_pk_bf16(v1[2], v1[3]);
                    *(v4u*)(rowp + bj * 128) = w; } }
    }
};
struct EpiResid {
    static constexpr bool PERM = false, AFTER_DRAIN = false;
    const float* sl; const float* sc; float* dl; float* dc; const float* gate; float mul = 1.f;
    __device__ __forceinline__ void operator()(const pg8::f32x4 (&acc)[2][2][4][2], const pg8::Unit& u, int wr, int wc, int fr, int fq) const {
        const int col0 = u.pn * 256 + wc * 32 + 4 * fq;
        const int r0 = u.pm * 256, b = r0 / TPB, t0 = r0 - b * TPB; const bool lat = t0 < SEQ;
        const float* sp0 = (lat ? sl + ((size_t)b * SEQ + t0) * DMODEL : sc + ((size_t)b * CTXL + (t0 - SEQ)) * DMODEL) + col0;
        float* dp0 = (lat ? dl + ((size_t)b * SEQ + t0) * DMODEL : dc + ((size_t)b * CTXL + (t0 - SEQ)) * DMODEL) + col0;
        const float* gp = gate + (size_t)(lat ? b : 4) * 6144 + col0;
        f32x4 gv[2][2];
#pragma unroll
        for (int bj = 0; bj < 2; ++bj)
#pragma unroll
            for (int n = 0; n < 2; ++n) gv[bj][n] = *(const f32x4*)(gp + bj * 128 + n * 16) * mul;
#pragma unroll
        for (int am = 0; am < 4; ++am) {
            const int ai = am >> 1, m0 = (am & 1) * 2;
            f32x4 xv[2][2][2];
#pragma unroll
            for (int mm = 0; mm < 2; ++mm) { const float* sp = sp0 + (size_t)(ai * 128 + wr * 64 + (m0 + mm) * 16 + fr) * DMODEL;
#pragma unroll
                for (int bj = 0; bj < 2; ++bj)
#pragma unroll
                    for (int n = 0; n < 2; ++n) xv[mm][bj][n] = *(const f32x4*)(sp + bj * 128 + n * 16); }
            asm volatile("" ::: "memory");
#pragma unroll
            for (int mm = 0; mm < 2; ++mm) { float* dp = dp0 + (size_t)(ai * 128 + wr * 64 + (m0 + mm) * 16 + fr) * DMODEL;
#pragma unroll
                for (int bj = 0; bj < 2; ++bj)
#pragma unroll
                    for (int n = 0; n < 2; ++n) { const f32x4 x = xv[mm][bj][n], g = gv[bj][n];
                        const pg8::f32x4 a = acc[ai][bj][m0 + mm][n]; f32x4 o; o.x = x.x + g.x * a[0]; o.y = x.y + g.y * a[1]; o.z = x.z + g.z * a[2]; o.w = x.w + g.w * a[3];
                        *(f32x4*)(dp + bj * 128 + n * 16) = o; } }
            asm volatile("" ::: "memory");
        }
    }
};

struct EpiConv {
    static constexpr bool PERM = true, AFTER_DRAIN = false;
    bf16* ACT; const float* cw; const float* cb;
    __device__ __forceinline__ void operator()(const pg8::f32x4 (&acc)[2][2][4][2], const pg8::Unit& u, int wr, int wc, int fr, int fq) const {
        const int j0 = u.pn * 128 + wc * 32 + 8 * fq;
        float w0[8], w1[8], w2[8], bb[8];
#pragma unroll
        for (int e = 0; e < 8; ++e) { w0[e] = cw[j0 + e]; w1[e] = cw[FFH + j0 + e]; w2[e] = cw[2 * FFH + j0 + e]; bb[e] = cb[j0 + e]; }
#pragma unroll
        for (int ai = 0; ai < 2; ++ai) {
            const int blk0 = u.pm * 248 + 62 * (2 * ai + wr) - 1;
#pragma unroll
            for (int m = 0; m < 4; ++m) {
                const int rho = 16 * m + fr, gr = blk0 + rho; const int ts = gr % TPB;
                const bool zp = (ts == 0) || (ts == SEQ), zn = (ts == SEQ - 1) || (ts == TPB - 1);
                unsigned ow[4];
#pragma unroll
                for (int n = 0; n < 2; ++n)
#pragma unroll
                    for (int e = 0; e < 4; e += 2) { float r2[2];
#pragma unroll
                        for (int q = 0; q < 2; ++q) { const int ee = e + q, ce = 4 * n + ee;
                            const float g = acc[ai][0][m][n][ee], v = acc[ai][1][m][n][ee];
                            const float gm1 = acc[ai][0][m > 0 ? m - 1 : 0][n][ee], gp1 = acc[ai][0][m < 3 ? m + 1 : 3][n][ee];
                            const float pa = __builtin_bit_cast(float, __builtin_amdgcn_update_dpp(0, __builtin_bit_cast(int, fr == 15 ? gm1 : g), 0x121, 0xf, 0xf, false));
                            const float na = __builtin_bit_cast(float, __builtin_amdgcn_update_dpp(0, __builtin_bit_cast(int, fr == 0 ? gp1 : g), 0x12F, 0xf, 0xf, false));
                            const float prev = zp ? 0.f : pa, next = zn ? 0.f : na;
                            const float t = w0[ce] * prev + w1[ce] * g + w2[ce] * next + bb[ce];
                            r2[q] = t * __builtin_amdgcn_rcpf(1.f + __expf(-t)) * v; }
                        ow[2 * n + (e >> 1)] = pg8::cvt_pk_bf16(r2[0], r2[1]); }
                if (rho >= 1 && rho <= 62 && gr < MROWS) *(v4u*)(ACT + (size_t)gr * FFH + j0) = (v4u){ow[0], ow[1], ow[2], ow[3]};
            }
        }
    }
};

__device__ __forceinline__ void ctx_strip_gemm(const Frame& F0, const bf16* A, int lda, const bf16* Wt, int K, const float* xc_src, float* xc_dst, const float* gate_ctx, int ncb = 16, bf16* outb = nullptr, int ldo = 0) {
    int tid = F0.wave0 * 64 + lane_asm(); asm volatile("" : "+v"(tid));
    const int lane = tid & 63, wave = __builtin_amdgcn_readfirstlane(tid >> 6), fr = lane & 15, fq = lane >> 4;
    LAS f32x4* red = (LAS f32x4*)F0.lds;
    const int kc = K >> 3;
    for (int it = F0.bid; it < 16 * ncb; it += F0.G) {
        const int rs = it / ncb, cb = it - rs * ncb;
        const bf16* ap[4]; const bf16* bp[4];
#pragma unroll
        for (int g = 0; g < 4; ++g) { const int cr = rs * 64 + g * 16 + fr, b = cr >> 8, t = cr & 255;
            ap[g] = A + ((size_t)b * TPB + SEQ + t) * lda + wave * kc + 8 * fq; bp[g] = Wt + (size_t)(cb * 64 + g * 16 + fr) * K + wave * kc + 8 * fq; }
        f32x4 acc[4][4];
#pragma unroll
        for (int rg = 0; rg < 4; ++rg)
#pragma unroll
            for (int cg = 0; cg < 4; ++cg) acc[rg][cg] = (f32x4){0.f, 0.f, 0.f, 0.f};
#pragma unroll 2
        for (int k0 = 0; k0 < kc; k0 += 32) {
            bf16x8 av[4], bv[4];
#pragma unroll
            for (int g = 0; g < 4; ++g) { av[g] = *(const bf16x8*)(ap[g] + k0); bv[g] = *(const bf16x8*)(bp[g] + k0); }
#pragma unroll
            for (int rg = 0; rg < 4; ++rg)
#pragma unroll
                for (int cg = 0; cg < 4; ++cg) acc[rg][cg] = __builtin_amdgcn_mfma_f32_16x16x32_bf16(bv[cg], av[rg], acc[rg][cg], 0, 0, 0);
        }
#pragma unroll
        for (int rg = 0; rg < 4; ++rg)
#pragma unroll
            for (int cg = 0; cg < 4; ++cg) red[(wave * 16 + rg * 4 + cg) * 64 + lane] = acc[rg][cg];
        __syncthreads();
#pragma unroll
        for (int h = 0; h < 2; ++h) { const int o = tid + 512 * h, tile = o >> 6, ln = o & 63, rg = tile >> 2, cg = tile & 3, ofr = ln & 15, ofq = ln >> 4;
            f32x4 s = red[o];
#pragma unroll
            for (int w = 1; w < 8; ++w) s += red[w * 1024 + o];
            const int cr = rs * 64 + rg * 16 + ofr, b = cr >> 8, t = cr & 255, col = cb * 64 + cg * 16 + 4 * ofq;
            if (outb) { v2u o; o.x = pk2(s.x, s.y); o.y = pk2(s.z, s.w); *(v2u*)(outb + ((size_t)b * TPB + SEQ + t) * ldo + col) = o; }
            else { const size_t xo = ((size_t)b * CTXL + t) * DMODEL + col;
                const f32x4 x0 = *(const f32x4*)(xc_src + xo), g0 = *(const f32x4*)(gate_ctx + col);
                *(f32x4*)(xc_dst + xo) = x0 + g0 * s; } }
        __syncthreads();
    }
}

__device__ __forceinline__ void transpose_item(const float* W, int K, int N, bf16* WT, LAS float* scr, int item, int lane, bool upmap = false) {
    const int nblk = N / 32, kb = item / nblk, nb = item % nblk, k0 = 64 * kb, n0 = 32 * nb;
    float wv[32];
#pragma unroll
    for (int i = 0; i < 32; ++i) wv[i] = W[(size_t)(k0 + 2 * i + (lane >> 5)) * N + n0 + (lane & 31)];
#pragma unroll
    for (int i = 0; i < 32; ++i) { const int kk = 2 * i + (lane >> 5); scr[kk * 33 + (lane & 31)] = wv[i]; }
    LDS_WAIT();
    const int c = lane & 7;
#pragma unroll
    for (int j = 0; j < 4; ++j) { const int n = (lane >> 3) + 8 * j; const LAS float* s = scr + (8 * c) * 33 + n;
        v4u o; o.x = pk2(s[0 * 33], s[1 * 33]); o.y = pk2(s[2 * 33], s[3 * 33]); o.z = pk2(s[4 * 33], s[5 * 33]); o.w = pk2(s[6 * 33], s[7 * 33]);
        const int nn = n0 + n, drow = !upmap ? nn : (nn < FFH ? 256 * (nn >> 7) + (nn & 127) : 256 * ((nn - FFH) >> 7) + 128 + ((nn - FFH) & 127));
        *(v4u*)(WT + (size_t)drow * K + k0 + 8 * c) = o; }
    LDS_WAIT();
}
typedef unsigned v4u_unused_;
#define RLX_AGENT __ATOMIC_RELAXED, __HIP_MEMORY_SCOPE_AGENT
#define XB_TMO      128
#define XB_XCNT(j)  (256  + 64 * (j))
#define XB_XSUB(j)  (1280 + 64 * (j))
#define XB_XGEN(j)  (2304 + 64 * (j))
#define XB_TOP      3328
#define XB_TOPGEN   3392
#define XCD_BAR_WORDS 3456
#define XB_SPIN_CAP (1u << 18)

__device__ __forceinline__ unsigned xb_ld(unsigned* p)              { return __hip_atomic_load(p, __ATOMIC_RELAXED, __HIP_MEMORY_SCOPE_AGENT); }
__device__ __forceinline__ unsigned xb_add(unsigned* p, unsigned v) { return __hip_atomic_fetch_add(p, v, __ATOMIC_RELAXED, __HIP_MEMORY_SCOPE_AGENT); }
__device__ __forceinline__ unsigned xb_xcc_id() { return (unsigned)__builtin_amdgcn_s_getreg((3 << 11) | 20) & 0xFu; }
#define XB_SPIN(cond, bar) do { unsigned _sp = 0; while (cond) { __builtin_amdgcn_s_sleep(1); \
    if ((++_sp & 255u) == 0u) { if (xb_ld(&(bar)[XB_TMO])) break; if (_sp > XB_SPIN_CAP) { atomicAdd(&(bar)[XB_TMO], 1u); break; } } } } while (0)

struct XcdBarrier {
    unsigned* bar; unsigned x;
    volatile LAS unsigned* st;
};

__device__ __forceinline__ XcdBarrier xcd_barrier_post(unsigned* bar, volatile LAS unsigned* st) {
    XcdBarrier b; b.bar = bar; b.x = xb_xcc_id(); b.st = st;
    if (threadIdx.x == 0) (void)xb_add(&bar[XB_XCNT(b.x)], 1u);
    return b;
}
__device__ __forceinline__ void xcd_barrier_complete(unsigned* bar, unsigned x, unsigned& nloc, unsigned& nx) {
    asm volatile("" : "+s"(bar));
    asm volatile("" : "+s"(x));
    const unsigned G = gridDim.x * gridDim.y * gridDim.z;
    unsigned sum, cnt, mine, sp = 0u;
    for (;;) {
        sum = 0u; cnt = 0u; mine = 0u;
#pragma unroll
        for (unsigned j = 0; j < 16; ++j) { const unsigned c = xb_ld(&bar[XB_XCNT(j)]); sum += c; cnt += (c > 0u) ? 1u : 0u; mine = (j == x) ? c : mine; }
        if (sum == G) break;
        __builtin_amdgcn_s_sleep(1);
        if ((++sp & 255u) == 0u) { if (xb_ld(&bar[XB_TMO])) break; if (sp > XB_SPIN_CAP) { atomicAdd(&bar[XB_TMO], 1u); break; } }
    }
    nloc = mine > 0u ? mine : 1u; nx = cnt > 0u ? cnt : 1u;
}

__device__ __forceinline__ void xcd_barrier(const XcdBarrier& b) {
    asm volatile("s_waitcnt vmcnt(0)" ::: "memory");
    __syncthreads();
    if (threadIdx.x == 0) {
        unsigned* bar = b.bar; asm volatile("" : "+s"(bar));
        __builtin_amdgcn_s_waitcnt(0);
        unsigned nloc = b.st[0], nx = b.st[1];
        if (nloc == 0u) { xcd_barrier_complete(bar, b.x, nloc, nx); b.st[0] = nloc; b.st[1] = nx; }
        const unsigned old = xb_add(&bar[XB_XSUB(b.x)], 1u);
        const unsigned gen = old / nloc;
        if (old + 1u == (gen + 1u) * nloc) {
            __builtin_amdgcn_fence(__ATOMIC_RELEASE, "agent");
            asm volatile("s_waitcnt vmcnt(0)" ::: "memory");
            const unsigned og = xb_add(&bar[XB_TOP], 1u);
            const unsigned tg = og / nx;
            if (og + 1u == (tg + 1u) * nx) xb_add(&bar[XB_TOPGEN], 1u);
            else XB_SPIN(xb_ld(&bar[XB_TOPGEN]) == tg, bar);
            __builtin_amdgcn_fence(__ATOMIC_ACQUIRE, "agent");
            xb_add(&bar[XB_XGEN(b.x)], 1u);
            asm volatile("s_waitcnt vmcnt(0)" ::: "memory");
        } else {
            XB_SPIN(xb_ld(&bar[XB_XGEN(b.x)]) == gen, bar);
            __builtin_amdgcn_fence(__ATOMIC_ACQUIRE, "agent");
            asm volatile("s_waitcnt vmcnt(0)" ::: "memory");
        }
    }
    __syncthreads();
}
__device__ __forceinline__ void p0_prologue(Frame& F0, const Args& a) {
    Frame F = F0; { int t_ = F0.wave0 * 64 + lane_asm(); asm volatile("" : "+v"(t_)); F.tid = t_; F.lane = t_ & 63; F.wave = __builtin_amdgcn_readfirstlane(t_ >> 6); } int lz = 0; asm volatile("" : "+s"(lz)); unsigned char* wsl = (unsigned char*)((unsigned long long)a.ws ^ (unsigned long long)(unsigned)lz);
    unsigned char* ws = wsl;
    float* MODS = (float*)(ws + WS_MODS);
    LAS float* sC = (LAS float*)F.lds;
    LAS float* red = sC + 5 * 1024;
    for (int i = F.tid; i < 5 * 1024; i += NTHREADS) { const float v = i < 4096 ? a.in[lz + I_C][i] : a.in[lz + I_CCTX][i - 4096]; sC[i] = v / (1.f + expf(-v)); }
    __syncthreads();
    for (int it = F.bid; it < 384; it += F.G) {
        const int l = it / 96, n0 = (it % 96) * 64, n = n0 + F.lane;
        const float* W = a.in[lz + I_WADA] + (size_t)l * 1024 * 6144 + n;
        float a0 = 0.f, a1 = 0.f, a2 = 0.f, a3 = 0.f, a4 = 0.f;
        const int k0 = F.wave * 128;
#pragma unroll 32
        for (int k = k0; k < k0 + 128; ++k) { const float w = W[(size_t)k * 6144];
            a0 += sC[k] * w; a1 += sC[1024 + k] * w; a2 += sC[2048 + k] * w; a3 += sC[3072 + k] * w; a4 += sC[4096 + k] * w; }
        red[(F.wave * 5 + 0) * 64 + F.lane] = a0; red[(F.wave * 5 + 1) * 64 + F.lane] = a1; red[(F.wave * 5 + 2) * 64 + F.lane] = a2;
        red[(F.wave * 5 + 3) * 64 + F.lane] = a3; red[(F.wave * 5 + 4) * 64 + F.lane] = a4;
        __syncthreads();
        if (F.tid < 320) { const int r = F.tid >> 6, ln = F.tid & 63; float s = 0.f;
#pragma unroll
            for (int w = 0; w < 8; ++w) s += red[(w * 5 + r) * 64 + ln];
            MODS[((size_t)l * 5 + r) * 6144 + n0 + ln] = s + a.in[lz + I_BADA][l * 6144 + n0 + ln]; }
        __syncthreads();
    }
    float* ROPE = (float*)(ws + WS_ROPE);
    for (int idx = F.bid * NTHREADS + F.tid; idx < SEQ * 32; idx += F.G * NTHREADS) {
        const int t = idx >> 5, pi = idx & 31, pos = pi < 16 ? (t >> 6) : (t & 63), m = pi & 15;
        const float inv = powf(10000.f, -(float)m / 16.f), ang = (float)pos * inv;
        ROPE[2 * idx] = cosf(ang); ROPE[2 * idx + 1] = sinf(ang);
    }
    float* H3L = (float*)(ws + WS_H3L); float* H3C = (float*)(ws + WS_H3C);
    const bool wtd = (F.G == 256); const int nslot = wtd ? 3072 : F.G * NWAVES; const int reps = (wtd && F.bid >= 128) ? 2 : 1;
    for (int rp = 0; rp < reps; ++rp)
    for (int item = (wtd ? (F.bid < 128 ? F.bid * 8 + F.wave : 1024 + (F.bid - 128) * 16 + rp * 8 + F.wave) : F.bid * NWAVES + F.wave); item < 2 * 8448; item += nslot) {
        const int i = item / 8448, rem = item % 8448, type = rem >= 8192 ? 1 : 0, p = type ? rem - 8192 : rem, L = type ? 256 : 8192;
        const int e = F.lane;
        const float tt = (float)p / (float)(L - 1);
        const float w = 6.283185307179586f * (float)p / (float)L;
        float zv = 0.f;
        if (e == 0) zv = tt;
        else if (e <= 32) { const int m = (e - 1) & 15; const float f = 1e-4f + (float)m * ((15.f - 1e-4f) / 15.f); const float ar = f * w; zv = e <= 16 ? cosf(ar) : -sinf(ar); }
        const float fr = a.in[lz + I_HFREQ][i * 64 + e];
        float acc = a.in[lz + I_HB1][i * 64 + e];
        for (int k = 0; k < 33; ++k) acc += shfl_l(zv, k) * a.in[lz + I_HW1][(i * 33 + k) * 64 + e];
        float h = sinf(fr * acc);
        acc = a.in[lz + I_HB2][i * 64 + e];
        for (int k = 0; k < 64; ++k) acc += shfl_l(h, k) * a.in[lz + I_HW2][(i * 64 + k) * 64 + e];
        h = sinf(fr * acc);
        acc = a.in[lz + I_HB3][i * 64 + e];
        for (int k = 0; k < 64; ++k) acc += shfl_l(h, k) * a.in[lz + I_HW3][(i * 64 + k) * 64 + e];
        h = sinf(fr * acc);
        if (type) H3C[((size_t)i * 256 + p) * 64 + e] = h; else H3L[((size_t)i * 8192 + p) * 64 + e] = h;
    }
}

__device__ __forceinline__ void norm_phase(Frame& F0, const float* xl, const float* xc, const float* mods_l, int shoff, bf16* H) {
    Frame F = F0; { int t_ = F0.wave0 * 64 + lane_asm(); asm volatile("" : "+v"(t_)); F.tid = t_; F.lane = t_ & 63; F.wave = __builtin_amdgcn_readfirstlane(t_ >> 6); } int lz = 0; asm volatile("" : "+s"(lz));
    const int gw = F.bid * NWAVES + F.wave, NGW = F.G * NWAVES;
    for (int row = gw; row < MROWS; row += 3 * NGW) {
        int rw[3]; bool ok[3]; const f32x4* xr[3]; f32x4 v[3][4];
#pragma unroll
        for (int q = 0; q < 3; ++q) { rw[q] = row + q * NGW; ok[q] = rw[q] < MROWS; if (!ok[q]) rw[q] = row; xr[q] = (const f32x4*)xrow_c(xl, xc, rw[q]) + F.lane;
#pragma unroll
            for (int j = 0; j < 4; ++j) v[q][j] = xr[q][64 * j]; }
#pragma unroll
        for (int q = 0; q < 3; ++q) {
            const float* md = mods_l + (size_t)modrow(rw[q]) * 6144 + shoff;
            float s = 0.f;
#pragma unroll
            for (int j = 0; j < 4; ++j) s += (v[q][j].x * v[q][j].x + v[q][j].y * v[q][j].y) + (v[q][j].z * v[q][j].z + v[q][j].w * v[q][j].w);
            const float r = 1.0f / sqrtf(wave_sum(s, F.lane) * (1.f / DMODEL) + EPS);
            unsigned long long* o8 = (unsigned long long*)(H + (size_t)rw[q] * DMODEL) + F.lane;
#pragma unroll
            for (int j = 0; j < 4; ++j) { const f32x4 sh = *((const f32x4*)md + F.lane + 64 * j), sc = *((const f32x4*)(md + 1024) + F.lane + 64 * j);
                const float y0 = v[q][j].x * r * (1.f + sc.x) + sh.x, y1 = v[q][j].y * r * (1.f + sc.y) + sh.y, y2 = v[q][j].z * r * (1.f + sc.z) + sh.z, y3 = v[q][j].w * r * (1.f + sc.w) + sh.w;
                if (ok[q]) o8[64 * j] = (unsigned long long)pk2(y0, y1) | ((unsigned long long)pk2(y2, y3) << 32); }
        }
    }
}

__device__ __forceinline__ void weights_phase(Frame& F0, const Args& a, int l) {
    Frame F = F0; { int t_ = F0.wave0 * 64 + lane_asm(); asm volatile("" : "+v"(t_)); F.tid = t_; F.lane = t_ & 63; F.wave = __builtin_amdgcn_readfirstlane(t_ >> 6); } int lz = 0; asm volatile("" : "+s"(lz)); unsigned char* wsl = (unsigned char*)((unsigned long long)a.ws ^ (unsigned long long)(unsigned)lz);
    unsigned char* ws = wsl; const int even = !(l & 1), i = l >> 1;
    const int nin = even ? NIN_E : NIN_O;
    const float* win = even ? a.in[lz + I_WINE] + (size_t)i * 1024 * NIN_E : a.in[lz + I_WINO] + (size_t)i * 1024 * NIN_O;
    const float* wout = (even ? a.in[lz + I_WOUTE] : a.in[lz + I_WOUTO]) + (size_t)i * 1024 * 1024;
    const float* wup = a.in[lz + I_WUP] + (size_t)l * 1024 * NUP;
    const float* wdown = a.in[lz + I_WDOWN] + (size_t)l * FFH * 1024;
    LAS float* scr = (LAS float*)(F.lds + F.wave * 16384);
    const int n_in = 16 * (nin / 32), n_out = 16 * 32, n_up = 16 * (NUP / 32), n_down = (FFH / 64) * 32;
    const int gw = F.bid * NWAVES + F.wave, NGW = F.G * NWAVES;
    for (int it = gw; it < n_in + n_out + n_up + n_down; it += NGW) {
        int r = it;
        if (r < n_in) { transpose_item(win, 1024, nin, (bf16*)(ws + WS_WIN), scr, r, F.lane); continue; } r -= n_in;
        if (r < n_out) { transpose_item(wout, 1024, 1024, (bf16*)(ws + WS_WOUT), scr, r, F.lane); continue; } r -= n_out;
        if (r < n_up) { transpose_item(wup, 1024, NUP, (bf16*)(ws + WS_WUP), scr, r, F.lane, true); continue; } r -= n_up;
        transpose_item(wdown, FFH, 1024, (bf16*)(ws + WS_WDOWN), scr, r, F.lane);
    }
}

__device__ __forceinline__ void filter_phase(Frame& F0, const Args& a, int l) {
    Frame F = F0; { int t_ = F0.wave0 * 64 + lane_asm(); asm volatile("" : "+v"(t_)); F.tid = t_; F.lane = t_ & 63; F.wave = __builtin_amdgcn_readfirstlane(t_ >> 6); } int lz = 0; asm volatile("" : "+s"(lz)); unsigned char* wsl = (unsigned char*)((unsigned long long)a.ws ^ (unsigned long long)(unsigned)lz);
    unsigned char* ws = wsl; const int i = l >> 1;
    const float* H3L = (const float*)(ws + WS_H3L); const float* H3C = (const float*)(ws + WS_H3C);
    float* FILT = (float*)(ws + WS_FILT); float* FILTC = (float*)(ws + WS_FILTC); float* PART = (float*)(ws + WS_PART);
    const float* w4 = a.in[lz + I_HW4] + (size_t)i * 64 * 1024;
    const float mind = logf(1e-2f) / 1.5f, maxd = logf(1e-2f) / 0.3f;
    LAS float* hs = (LAS float*)(F.lds + F.wave * 16896);
    const int nitem = 2048 + (l == 1 ? 64 : 0);
    const int gw = F.bid * NWAVES + F.wave, NGW = F.G * NWAVES;
    for (int it = gw; it < nitem; it += NGW) {
        const int type = it >= 2048 ? 1 : 0, r = type ? it - 2048 : it, cg = r & 15, chunk = r >> 4, L = type ? 256 : 8192;
        const float* h3 = (type ? H3C + (size_t)i * 256 * 64 : H3L + (size_t)i * 8192 * 64) + (size_t)chunk * 64 * 64;
#pragma unroll 4
        for (int j = 0; j < 16; ++j) { const int e4 = (j * 64 + F.lane) * 4; const f32x4 v = *(const f32x4*)(h3 + e4); LAS float* d = hs + (e4 >> 6) * 65 + (e4 & 63); d[0] = v.x; d[1] = v.y; d[2] = v.z; d[3] = v.w; }
        LDS_WAIT();
        const int p = chunk * 64 + F.lane;
        const float tt = (float)p / (float)(L - 1);
        float acc[32], acb[32];
#pragma unroll
        for (int cc = 0; cc < 32; ++cc) { acc[cc] = 0.f; acb[cc] = 0.f; }
        const float* wrow = w4 + cg * 32 + (F.lane < 32 ? F.lane : 512 + F.lane - 32);
#pragma unroll 8
        for (int k = 0; k < 64; ++k) { const float hv = hs[F.lane * 65 + k]; const float wk = wrow[k * 1024];
#pragma unroll
            for (int cc = 0; cc < 32; ++cc) { acc[cc] += hv * __builtin_bit_cast(float, __builtin_amdgcn_readlane(__builtin_bit_cast(int, wk), cc));
                                              acb[cc] += hv * __builtin_bit_cast(float, __builtin_amdgcn_readlane(__builtin_bit_cast(int, wk), 32 + cc)); } }
        float mys = 0.f;
#pragma unroll
        for (int cc = 0; cc < 32; ++cc) {
            const int c = cg * 32 + cc;
            const float delta = fabsf(mind + (float)c * ((maxd - mind) / 511.f)), decay = expf(-tt * delta);
            const float hf = acc[cc] * decay, hb = acb[cc] * decay;
            if (type) { FILTC[(size_t)c * 512 + p] = hf; FILTC[(size_t)c * 512 + 256 + p] = hb; }
            else { FILT[(size_t)c * 16384 + p] = hf; FILT[(size_t)c * 16384 + 8192 + p] = hb; }
            float s = fabsf(hf) + (p >= 1 ? fabsf(hb) : 0.f); s = wave_sum(s, F.lane);
            mys = (F.lane == cc) ? s : mys;
        }
        if (F.lane < 32) PART[(size_t)(type * 128 + chunk) * 512 + cg * 32 + F.lane] = mys;
        LDS_WAIT();
    }
}

__device__ __forceinline__ v4u qk_compute(v4u w, const float* gain, bool isq, bool rope, const float* rp, int lane) {
    float x[8] = {bflo(w.x), bfhi(w.x), bflo(w.y), bfhi(w.y), bflo(w.z), bfhi(w.z), bflo(w.w), bfhi(w.w)};
    float ss = 0.f;
#pragma unroll
    for (int e = 0; e < 8; ++e) ss += x[e] * x[e];
    ss += shfl_l(ss, lane ^ 1); ss += shfl_l(ss, lane ^ 2); ss += shfl_l(ss, lane ^ 4);
    const float r = 1.0f / sqrtf(ss * (1.f / 64.f) + EPS);
    const f32x4 g0 = *(const f32x4*)(gain + (lane & 7) * 8), g1 = *(const f32x4*)(gain + (lane & 7) * 8 + 4);
    x[0] *= r * g0.x; x[1] *= r * g0.y; x[2] *= r * g0.z; x[3] *= r * g0.w; x[4] *= r * g1.x; x[5] *= r * g1.y; x[6] *= r * g1.z; x[7] *= r * g1.w;
    if (rope) { const f32x4 c0 = *(const f32x4*)(rp + (lane & 7) * 8), c1 = *(const f32x4*)(rp + (lane & 7) * 8 + 4);
        float t0;
        t0 = x[0] * c0.x - x[1] * c0.y; x[1] = x[0] * c0.y + x[1] * c0.x; x[0] = t0;
        t0 = x[2] * c0.z - x[3] * c0.w; x[3] = x[2] * c0.w + x[3] * c0.z; x[2] = t0;
        t0 = x[4] * c1.x - x[5] * c1.y; x[5] = x[4] * c1.y + x[5] * c1.x; x[4] = t0;
        t0 = x[6] * c1.z - x[7] * c1.w; x[7] = x[6] * c1.w + x[7] * c1.z; x[6] = t0; }
    if (isq) {
#pragma unroll
        for (int e = 0; e < 8; ++e) x[e] *= QSCALE; }
    v4u o; o.x = pk2(x[0], x[1]); o.y = pk2(x[2], x[3]); o.z = pk2(x[4], x[5]); o.w = pk2(x[6], x[7]); return o;
}
__device__ __forceinline__ void qknorm_phase(Frame& F0, const Args& a, int l, bf16* U, int dry = 0) {
    Frame F = F0; { int t_ = F0.wave0 * 64 + lane_asm(); asm volatile("" : "+v"(t_)); F.tid = t_; F.lane = t_ & 63; F.wave = __builtin_amdgcn_readfirstlane(t_ >> 6); } int lz = 0; asm volatile("" : "+s"(lz)); unsigned char* wsl = (unsigned char*)((unsigned long long)a.ws ^ (unsigned long long)(unsigned)lz);
    const int even = !(l & 1), i = l >> 1, pitch = even ? NIN_E : NIN_O;
    const float* ROPE = (const float*)(wsl + WS_ROPE);
    const int gw = F.bid * NWAVES + F.wave, NGW = F.G * NWAVES;
    if (even) {
        const float *g0 = a.in[lz + I_NAQG] + i * 64, *g1 = a.in[lz + I_NAKG] + i * 64, *g2 = a.in[lz + I_DAQG] + i * 64, *g3 = a.in[lz + I_DAKG] + i * 64;
        for (int row = gw; row < MROWS; row += 2 * NGW) {
            const int row1 = row + NGW; const bool has1 = row1 < MROWS;
            bf16* u0 = U + (size_t)row * pitch + F.lane * 8; bf16* u1 = U + (size_t)(has1 ? row1 : row) * pitch + F.lane * 8;
            const v4u a0 = *(const v4u*)u0, a1 = *(const v4u*)(u0 + 512), a2 = *(const v4u*)(u0 + 1536), a3 = *(const v4u*)(u0 + 2048);
            const v4u b0 = *(const v4u*)u1, b1 = *(const v4u*)(u1 + 512), b2 = *(const v4u*)(u1 + 1536), b3 = *(const v4u*)(u1 + 2048);
            const int t0 = row % TPB, t1 = (has1 ? row1 : row) % TPB; const bool l0 = t0 < SEQ, l1 = t1 < SEQ;
            const float* rp0 = ROPE + (size_t)(l0 ? t0 : 0) * 64; const float* rp1 = ROPE + (size_t)(l1 ? t1 : 0) * 64;
            const v4u o0 = qk_compute(a0, g0, true, false, rp0, F.lane), o1 = qk_compute(a1, g1, false, false, rp0, F.lane), o2 = qk_compute(a2, g2, true, l0, rp0, F.lane), o3 = qk_compute(a3, g3, false, l0, rp0, F.lane);
            const v4u p0 = qk_compute(b0, g0, true, false, rp1, F.lane), p1 = qk_compute(b1, g1, false, false, rp1, F.lane), p2 = qk_compute(b2, g2, true, l1, rp1, F.lane), p3 = qk_compute(b3, g3, false, l1, rp1, F.lane);
            if (dry && (o0.x ^ o1.x ^ o2.x ^ o3.x ^ p0.x ^ p1.x ^ p2.x ^ p3.x) != 0x12345678u) continue;
            *(v4u*)u0 = o0; *(v4u*)(u0 + 512) = o1; *(v4u*)(u0 + 1536) = o2; *(v4u*)(u0 + 2048) = o3;
            if (has1) { *(v4u*)u1 = p0; *(v4u*)(u1 + 512) = p1; *(v4u*)(u1 + 1536) = p2; *(v4u*)(u1 + 2048) = p3; }
        }
    } else {
        const float *g0 = a.in[lz + I_GQG] + i * 64, *g1 = a.in[lz + I_GKG] + i * 64;
        const bool kact = F.lane < 16;
        for (int row = gw; row < MROWS; row += 2 * NGW) {
            const int row1 = row + NGW; const bool has1 = row1 < MROWS;
            bf16* u0 = U + (size_t)row * pitch + F.lane * 8; bf16* u1 = U + (size_t)(has1 ? row1 : row) * pitch + F.lane * 8;
            const v4u zero = {0u, 0u, 0u, 0u};
            const v4u a0 = *(const v4u*)u0, a1 = kact ? *(const v4u*)(u0 + 512) : zero;
            const v4u b0 = *(const v4u*)u1, b1 = kact ? *(const v4u*)(u1 + 512) : zero;
            const int t0 = row % TPB, t1 = (has1 ? row1 : row) % TPB; const bool l0 = t0 < SEQ, l1 = t1 < SEQ;
            const float* rp0 = ROPE + (size_t)(l0 ? t0 : 0) * 64; const float* rp1 = ROPE + (size_t)(l1 ? t1 : 0) * 64;
            const v4u o0 = qk_compute(a0, g0, true, l0, rp0, F.lane), o1 = qk_compute(a1, g1, false, l0, rp0, F.lane);
            const v4u p0 = qk_compute(b0, g0, true, l1, rp1, F.lane), p1 = qk_compute(b1, g1, false, l1, rp1, F.lane);
            if (dry && (o0.x ^ o1.x ^ p0.x ^ p1.x) != 0x12345678u) continue;
            *(v4u*)u0 = o0; if (kact) *(v4u*)(u0 + 512) = o1;
            if (has1) { *(v4u*)u1 = p0; if (kact) *(v4u*)(u1 + 512) = p1; }
        }
    }
}
__device__ __forceinline__ void hyprep_phase(Frame& F0, const Args& a, int l, const bf16* U) {
    Frame F = F0; { int t_ = F0.wave0 * 64 + lane_asm(); asm volatile("" : "+v"(t_)); F.tid = t_; F.lane = t_ & 63; F.wave = __builtin_amdgcn_readfirstlane(t_ >> 6); } int lz = 0; asm volatile("" : "+s"(lz)); unsigned char* wsl = (unsigned char*)((unsigned long long)a.ws ^ (unsigned long long)(unsigned)lz);
    const int i = l >> 1;
    bf16* ZT = (bf16*)(wsl + WS_ZT); bf16* X0T = (bf16*)(wsl + WS_X0T);
    LAS bf16* zs = (LAS bf16*)F.lds; LAS bf16* xs = zs + 128 * 66;
    if (F.bid == (F.G > 1 ? 1 : 0)) { float* INV = (float*)(wsl + WS_PART) + 132 * 512; const float* PART = (const float*)(wsl + WS_PART);
        { float s = 0.f; for (int k = 0; k < 128; ++k) s += PART[(size_t)k * 512 + F.tid]; INV[F.tid] = 1.0f / s; }
        if (l == 1) { float s = 0.f; for (int k = 0; k < 4; ++k) s += PART[(size_t)(128 + k) * 512 + F.tid]; INV[512 + F.tid] = 1.0f / s; } }
    const float* cw = a.in[lz + I_HCW] + (size_t)i * 3 * 1536; const float* cb = a.in[lz + I_HCB] + (size_t)i * 1536;
    const int cp = F.tid & 63, tq = F.tid >> 6;
    for (int it = F.bid; it < 2048; it += F.G) {
        const int cgp = it & 3, tile = it >> 2, b = tile >> 7, t0 = (tile & 127) * 64;
        const size_t rowb = (size_t)b * TPB;
        const int tb = t0 + tq * 8;
        float res[3][8][2];
#pragma unroll
        for (int part = 0; part < 3; ++part) {
            const int cc = part * 512 + cgp * 128 + 2 * cp;
            const float w0a = cw[cc], w0b = cw[cc + 1], w1a = cw[1536 + cc], w1b = cw[1536 + cc + 1], w2a = cw[3072 + cc], w2b = cw[3072 + cc + 1], ba = cb[cc], bb = cb[cc + 1];
            unsigned ua[10];
#pragma unroll
            for (int k = 0; k < 10; ++k) { const int tt = tb - 1 + k; ua[k] = (tt >= 0 && tt < SEQ) ? *(const unsigned*)(U + (rowb + tt) * NIN_O + 768 + cc) : 0u; }
#pragma unroll
            for (int k = 0; k < 8; ++k) { res[part][k][0] = w0a * bflo(ua[k]) + w1a * bflo(ua[k + 1]) + w2a * bflo(ua[k + 2]) + ba;
                                          res[part][k][1] = w0b * bfhi(ua[k]) + w1b * bfhi(ua[k + 1]) + w2b * bfhi(ua[k + 2]) + bb; }
        }
#pragma unroll
        for (int k = 0; k < 8; ++k) {
            zs[(2 * cp) * 66 + tq * 8 + k] = (bf16)f2bf(res[2][k][0] * res[1][k][0]); zs[(2 * cp + 1) * 66 + tq * 8 + k] = (bf16)f2bf(res[2][k][1] * res[1][k][1]);
            xs[(2 * cp) * 66 + tq * 8 + k] = (bf16)f2bf(res[0][k][0]);               xs[(2 * cp + 1) * 66 + tq * 8 + k] = (bf16)f2bf(res[0][k][1]);
        }
        __syncthreads();
        { const int c = F.tid >> 2, q = F.tid & 3; const size_t go = (size_t)(cgp * 128 + c) * (NBATCH * SEQ) + (size_t)b * SEQ + t0 + q * 16;
          const LAS unsigned* zr = (const LAS unsigned*)(zs + c * 66 + q * 16); const LAS unsigned* xr = (const LAS unsigned*)(xs + c * 66 + q * 16);
          v4u z0 = {zr[0], zr[1], zr[2], zr[3]}, z1 = {zr[4], zr[5], zr[6], zr[7]}, x0 = {xr[0], xr[1], xr[2], xr[3]}, x1 = {xr[4], xr[5], xr[6], xr[7]};
          *(v4u*)(ZT + go) = z0; *(v4u*)(ZT + go + 8) = z1; *(v4u*)(X0T + go) = x0; *(v4u*)(X0T + go + 8) = x1; }
        __syncthreads();
    }
}

struct DenseMap { static constexpr bool HAS_MASK = false;
    __device__ __forceinline__ int row(int t) const { return 64 * t; }
    __device__ __forceinline__ void mask(f32x16&, f32x16&, int, int, int) const {} };
struct NaMap { static constexpr bool HAS_MASK = true; int rlo, qr0; const LAS float* tab;
    __device__ __forceinline__ int row(int t) const { const int kr = rlo + t - 4; return t < 4 ? SEQ + 64 * t : (kr > 127 ? 127 : kr) * 64; }
    __device__ __forceinline__ void mask(f32x16& p0, f32x16& p1, int t, int qrel, int hi) const {
        if (t < 4) return;
        const int kr = rlo + t - 4, qr = qr0 + (qrel >> 6), r0q = (qr - 4 < 0) ? 0 : (qr - 4 > 120 ? 120 : qr - 4);
        const bool rowok = (kr >= r0q) && (kr <= r0q + 7);
        const int qc = qrel & 63, c0 = (qc - 8 < 0) ? 0 : (qc - 8 > 48 ? 48 : qc - 8);
        const float NEG = -INFINITY;
        if (!rowok) {
#pragma unroll
            for (int r = 0; r < 16; ++r) { p0[r] = NEG; p1[r] = NEG; }
        } else {
            const LAS float* tb = tab + (kr - qr + 7) * 31 + 15 - qc;
#pragma unroll
            for (int r = 0; r < 16; ++r) { const int kc = (r & 3) + 8 * (r >> 2) + 4 * hi;
                const bool ok0 = (unsigned)(kc - c0) < 16u, ok1 = (unsigned)(kc + 32 - c0) < 16u;
                const float b0 = tb[kc], b1 = tb[kc + 32];
                p0[r] = ok0 ? p0[r] + b0 : NEG; p1[r] = ok1 ? p1[r] + b1 : NEG; }
        }
    } };

__device__ __forceinline__ int q_next(Frame& F, unsigned* ctr, int x, int nloc) {
    volatile LAS int* w = (volatile LAS int*)(F.lds + MISC_OFF);
    __syncthreads();
    if (F.tid == 0) { int res = -1;
        for (int k = 0; k < 8; ++k) { const int xx = (x + k) & 7; const unsigned n = atomicAdd(ctr + xx * 64, 1u); if (n < (unsigned)nloc) { res = xx * 65536 + (int)n; break; } }
        w[0] = res; }
    __syncthreads();
    return __builtin_amdgcn_readfirstlane(w[0]);
}

__device__ __forceinline__ void hyena_unit(Frame& F0, const Args& a, int l, int c, int dry) {
    Frame F = F0; { int t_ = F0.wave0 * 64 + lane_asm(); asm volatile("" : "+v"(t_)); F.tid = t_; F.lane = t_ & 63; F.wave = __builtin_amdgcn_readfirstlane(t_ >> 6); } int lz = 0; asm volatile("" : "+s"(lz)); unsigned char* wsl = (unsigned char*)((unsigned long long)a.ws ^ (unsigned long long)(unsigned)lz);
    const int i = l >> 1;
    const float* FILT = (const float*)(wsl + WS_FILT) + (size_t)c * 16384;
    const bf16* ZT = (const bf16*)(wsl + WS_ZT) + (size_t)c * (NBATCH * SEQ); bf16* X0T = (bf16*)(wsl + WS_X0T) + (size_t)c * (NBATCH * SEQ);
    const float inv = ((const float*)(wsl + WS_PART) + 132 * 512)[c];
    const float skipc = a.in[lz + I_HSKIP][i * 512 + c];
    LAS bf16* RA = (LAS bf16*)F.lds;
    LAS bf16* RB = (LAS bf16*)(F.lds + 32768 + 64);
    LAS bf16* zl = (LAS bf16*)(F.lds + 65536 + 64);
#define HY_ZIDX(bq_, t_) ((bq_) * 8736 + ((t_) >> 7) * 136 + ((t_) & 127))
    f32x4 fv[4], fw[4]; v4u zq[8];
#pragma unroll
    for (int q = 0; q < 4; ++q) { const int j = F.tid * 4 + q * NTHREADS * 4; fv[q] = *(const f32x4*)(FILT + j); fw[q] = *(const f32x4*)(FILT + 8192 + j); }
#pragma unroll
    for (int q = 0; q < 8; ++q) zq[q] = *(const v4u*)(ZT + F.tid * 8 + q * NTHREADS * 8);
#pragma unroll
    for (int q = 0; q < 4; ++q) { const int j = F.tid * 4 + q * NTHREADS * 4; const f32x4 vf = fv[q], vb = fw[q];
        const float ff[4] = {vf.x, vf.y, vf.z, vf.w}, fb[4] = {vb.x, vb.y, vb.z, vb.w};
#pragma unroll
        for (int e = 0; e < 4; ++e) { const int pp = j + e; const bf16 hf = (bf16)f2bf(ff[e] * inv), hb = (bf16)f2bf(fb[e] * inv);
            RA[8191 - pp] = hf; if (8191 - pp >= 1) RB[8190 - pp] = hf;
            if (pp >= 1) { RA[8191 + pp] = hb; RB[8190 + pp] = hb; } } }
#pragma unroll
    for (int q = 0; q < 8; ++q) { const int j = F.tid * 8 + q * NTHREADS * 8; *(LAS v4u*)(zl + HY_ZIDX(j >> 13, j & 8191)) = zq[q]; }
    __syncthreads();
    const int w = F.wave, n = F.lane & 31, kg = F.lane >> 5, ii = 8 * w + (n >> 2), bb = n & 3;
    const unsigned abase = (n & 1) ? (unsigned)(uintptr_t)(RA + (8191 - n + 8 * kg)) : (unsigned)(uintptr_t)(RB + (8190 - n + 8 * kg));
    f32x16 acc[4];
#pragma unroll
    for (int m = 0; m < 4; ++m) acc[m] = f32x16{};
    v2u af[14][2], an[8][2]; v4u bq[8], bn[8];
#define HY_LDA(dst, g, addr) do { asm volatile("ds_read2_b32 %0, %1 offset0:%2 offset1:%3" : "=v"(dst[0]) : "v"(addr), "n"(104 - 8 * (g)), "n"(105 - 8 * (g)) : "memory"); \
                                  asm volatile("ds_read2_b32 %0, %1 offset0:%2 offset1:%3" : "=v"(dst[1]) : "v"(addr), "n"(106 - 8 * (g)), "n"(107 - 8 * (g)) : "memory"); } while (0)
#define HY_LDB(dst, ks, zaddr) asm volatile("ds_read_b128 %0, %1 offset:%2" : "=v"(dst) : "v"(zaddr), "n"((ks) * 32) : "memory")
#define HY_ISSUE(dd) do { const unsigned addr_ = abase + (unsigned)((-64 * (dd) - 48) * 4);     \
        HY_LDA(an[0], 6, addr_); HY_LDA(an[1], 7, addr_); HY_LDA(an[2], 8, addr_); HY_LDA(an[3], 9, addr_); HY_LDA(an[4], 10, addr_); HY_LDA(an[5], 11, addr_); HY_LDA(an[6], 12, addr_); HY_LDA(an[7], 13, addr_); \
        const int jb_ = ii - (dd); const unsigned zaddr_ = (unsigned)(uintptr_t)(zl + bb * 8736 + ((unsigned)jb_ < 64u ? jb_ : 0) * 136 + kg * 8); \
        HY_LDB(bn[0], 0, zaddr_); HY_LDB(bn[1], 1, zaddr_); HY_LDB(bn[2], 2, zaddr_); HY_LDB(bn[3], 3, zaddr_); HY_LDB(bn[4], 4, zaddr_); HY_LDB(bn[5], 5, zaddr_); HY_LDB(bn[6], 6, zaddr_); HY_LDB(bn[7], 7, zaddr_); } while (0)
    const int d0 = 8 * w - 63, dlast = 8 * w + 7;
    { const unsigned addr = abase + (unsigned)((-64 * d0 - 48) * 4);
      HY_LDA(af[8], 0, addr); HY_LDA(af[9], 1, addr); HY_LDA(af[10], 2, addr); HY_LDA(af[11], 3, addr); HY_LDA(af[12], 4, addr); HY_LDA(af[13], 5, addr); }
    HY_ISSUE(d0);
    for (int d = d0; d <= dlast; ++d) {
        asm volatile("s_waitcnt lgkmcnt(0)" ::: "memory");
#pragma unroll
        for (int g = 8; g < 14; ++g) asm volatile("" : "+v"(af[g][0]), "+v"(af[g][1]));
#pragma unroll
        for (int g = 0; g < 8; ++g) asm volatile("" : "+v"(an[g][0]), "+v"(an[g][1]), "+v"(bn[g]));
#pragma unroll
        for (int g = 0; g < 6; ++g) { af[g][0] = af[g + 8][0]; af[g][1] = af[g + 8][1]; }
#pragma unroll
        for (int g = 0; g < 8; ++g) { af[6 + g][0] = an[g][0]; af[6 + g][1] = an[g][1]; bq[g] = bn[g]; }
#pragma unroll
        for (int g = 0; g < 14; ++g) asm volatile("" : "+v"(af[g][0]), "+v"(af[g][1]));
#pragma unroll
        for (int g = 0; g < 8; ++g) asm volatile("" : "+v"(bq[g]));
        if (d < dlast) HY_ISSUE(d + 1);
        const int jb = ii - d; const bool valid = (unsigned)jb < 64u;
#pragma unroll
        for (int ks = 0; ks < 8; ++ks) {
            bf16x8 bfr = __builtin_bit_cast(bf16x8, bq[ks]);
            if (!valid) bfr = bf16x8{};
#pragma unroll
            for (int mt = 0; mt < 4; ++mt) { const int g = 2 * mt - ks + 7; const v4u aw = {af[g][0].x, af[g][0].y, af[g][1].x, af[g][1].y};
                acc[mt] = __builtin_amdgcn_mfma_f32_32x32x16_bf16(__builtin_bit_cast(bf16x8, aw), bfr, acc[mt], 0, 0, 0); }
        }
    }
#undef HY_LDA
#undef HY_LDB
#undef HY_ISSUE
    __syncthreads();
    LAS bf16* yt = (LAS bf16*)F.lds + w * 4096;
#pragma unroll
    for (int mt = 0; mt < 4; ++mt)
#pragma unroll
        for (int v = 0; v < 16; ++v) { const int tl = (n >> 2) * 128 + 32 * mt + (v & 3) + 8 * (v >> 2) + 4 * kg; yt[bb * 1024 + (tl & ~127) + ((((tl & 127) >> 3) ^ (n >> 2)) << 3) + (tl & 7)] = (bf16)f2bf(acc[mt][v]); }
    LDS_WAIT();
#pragma unroll
    for (int it = 0; it < 8; ++it) { const int e = (it * 64 + F.lane) * 8, b2 = e >> 10, tl = e & 1023; const size_t go = (size_t)b2 * SEQ + 1024 * w + tl;
        const v4u xv = *(const v4u*)(X0T + go), zv = *(const LAS v4u*)(zl + HY_ZIDX(b2, 1024 * w + tl)), yv = *(const LAS v4u*)(yt + (e & ~127) + ((((e & 127) >> 3) ^ ((e >> 7) & 7)) << 3));
        const unsigned xa[4] = {xv.x, xv.y, xv.z, xv.w}, za[4] = {zv.x, zv.y, zv.z, zv.w}, ya[4] = {yv.x, yv.y, yv.z, yv.w}; unsigned oo[4];
#pragma unroll
        for (int q = 0; q < 4; ++q) oo[q] = pk2(bflo(xa[q]) * (bflo(ya[q]) + skipc * bflo(za[q])), bfhi(xa[q]) * (bfhi(ya[q]) + skipc * bfhi(za[q])));
        if (dry && oo[0] != 0x12345678u) { oo[0] = xa[0]; oo[1] = xa[1]; oo[2] = xa[2]; oo[3] = xa[3]; }
        *(v4u*)(X0T + go) = (v4u){oo[0], oo[1], oo[2], oo[3]}; }
}
#undef HY_ZIDX

__device__ __forceinline__ void hyena_ctx_item(Frame& F0, const Args& a, int l, int item, const bf16* U) {
    Frame F = F0; { int t_ = F0.wave0 * 64 + lane_asm(); asm volatile("" : "+v"(t_)); F.tid = t_; F.lane = t_ & 63; F.wave = __builtin_amdgcn_readfirstlane(t_ >> 6); } int lz = 0; asm volatile("" : "+s"(lz)); unsigned char* wsl = (unsigned char*)((unsigned long long)a.ws ^ (unsigned long long)(unsigned)lz);
    const int i = l >> 1, c = item * 8 + F.wave, lane = F.lane;
    LAS float* fl = (LAS float*)(F.lds + F.wave * 16384);
    LAS float* zl = fl + 512;
    LAS float* xl = zl + 1024;
    const float* FILTC = (const float*)(wsl + WS_FILTC) + (size_t)c * 512;
    const float inv = ((const float*)(wsl + WS_PART) + 132 * 512 + 512)[c];
    const float skipc = a.in[lz + I_HSKIP][i * 512 + c];
    bf16* YTC = (bf16*)(wsl + WS_YTC) + (size_t)c * 1024;
    const float* cw = a.in[lz + I_HCW] + (size_t)i * 3 * 1536; const float* cb = a.in[lz + I_HCB] + (size_t)i * 1536;
    for (int j = lane; j < 256; j += 64) { fl[255 + j] = FILTC[j] * inv; if (j > 0) fl[255 - j] = FILTC[256 + j] * inv; }
    if (lane == 0) fl[511] = 0.f;
    float cwv[3][3], cbv[3];
#pragma unroll
    for (int part = 0; part < 3; ++part) { const int cc = part * 512 + c; cwv[part][0] = cw[cc]; cwv[part][1] = cw[1536 + cc]; cwv[part][2] = cw[3072 + cc]; cbv[part] = cb[cc]; }
    for (int b = 0; b < 4; ++b) {
        unsigned short uu[4][3][3];
#pragma unroll
        for (int k = 0; k < 4; ++k) { const int t = lane + 64 * k;
#pragma unroll
            for (int part = 0; part < 3; ++part) { const bf16* up = U + ((size_t)b * TPB + SEQ + t) * NIN_O + 768 + part * 512 + c;
                uu[k][part][0] = t > 0 ? up[-NIN_O] : (unsigned short)0; uu[k][part][1] = up[0]; uu[k][part][2] = t < 255 ? up[NIN_O] : (unsigned short)0; } }
#pragma unroll
        for (int k = 0; k < 4; ++k) { const int t = lane + 64 * k; float r3[3];
#pragma unroll
            for (int part = 0; part < 3; ++part) r3[part] = cwv[part][0] * bf2f(uu[k][part][0]) + cwv[part][1] * bf2f(uu[k][part][1]) + cwv[part][2] * bf2f(uu[k][part][2]) + cbv[part];
            zl[b * 256 + t] = r3[2] * r3[1]; xl[b * 256 + t] = r3[0]; }
    }
    LDS_WAIT();
    for (int k = 0; k < 4; ++k) { const int t = lane + 64 * k; float y0 = 0.f, y1 = 0.f, y2 = 0.f, y3 = 0.f;
        for (int s = 0; s < 256; ++s) { const float f = fl[t - s + 255]; y0 += f * zl[s]; y1 += f * zl[256 + s]; y2 += f * zl[512 + s]; y3 += f * zl[768 + s]; }
        const float yy[4] = {y0, y1, y2, y3};
#pragma unroll
        for (int b = 0; b < 4; ++b) YTC[b * 256 + t] = (bf16)f2bf(xl[b * 256 + t] * (yy[b] + skipc * zl[b * 256 + t])); }
}

__device__ __forceinline__ void mixer_phase(Frame& F0, const Args& a, int l, char* ldsg, int qslot, int dry) {
    Frame F = F0; { int t_ = F0.wave0 * 64 + lane_asm(); asm volatile("" : "+v"(t_)); F.tid = t_; F.lane = t_ & 63; F.wave = __builtin_amdgcn_readfirstlane(t_ >> 6); } int lz = 0; asm volatile("" : "+s"(lz)); unsigned char* wsl = (unsigned char*)((unsigned long long)a.ws ^ (unsigned long long)(unsigned)lz);
    using abf = attn_body::bf16;
    const int even = !(l & 1), i = l >> 1;
    unsigned* ctr = (unsigned*)(wsl + WS_CTL) + CW_QUEUE + 512 * qslot;
    const int xcd = (int)(xb_xcc_id() & 7u);
    const bf16* U = (const bf16*)(wsl + WS_U); bf16* MIX = (bf16*)(wsl + WS_H); bf16* DAO = (bf16*)(wsl + WS_DAO);
    const int nloc = even ? 396 : (l == 1 ? 204 : 196);
    LAS float* tab = (LAS float*)(F.lds + 86016);
    for (;;) {
        const int qv = q_next(F, ctr, xcd, nloc);
        if (qv < 0) break;
        int id; { const int xx = qv >> 16, n = qv & 65535;
            if (even) { if (n < 256) id = (8 * (n >> 5) + xx) * 32 + (n & 31);
                        else if (n < 384) id = 2048 + (8 * ((n - 256) >> 5) + xx) * 32 + (n & 31);
                        else if (n < 392) id = 3072 + 8 * (n - 384) + xx;
                        else id = 3136 + 8 * (n - 392) + xx; }
            else { if (n < 64) id = 8 * n + xx;
                   else if (n < 192) { const int m = n - 64, b = xx >> 1, h = (xx & 1) * 4 + (m >> 5); id = 512 + (b * 8 + h) * 32 + (m & 31); }
                   else if (n < 196) { const int b = xx >> 1, h = (xx & 1) * 4 + (n - 192); id = 1536 + b * 8 + h; }
                   else id = 1568 + 8 * (n - 196) + xx; } }
        const bf16 *Q, *K, *V; bf16* O; int pin, NT = 132, po = 1024; bool isna = false; int na_qb = 0, na_h = 0;
        if (even) {
            pin = NIN_E;
            if (id < 2048) { const int qb = id & 31, x = id >> 5, half = x & 1, comp = (x >> 1) & 1, hd = (x >> 2) & 3, b = x >> 4; const size_t rb = (size_t)b * TPB;
                Q = U + (rb + qb * 256) * NIN_E + 1536 + (2 * hd + comp) * 64; K = U + rb * NIN_E + 2048 + (2 * hd + comp) * 64; V = U + rb * NIN_E + 2560 + hd * 128 + half * 64;
                O = DAO + (rb + qb * 256) * 1024 + ((hd * 2 + comp) * 2 + half) * 64; }
            else if (id < 3072) { const int y = id - 2048, qb = y & 31, h = (y >> 5) & 7, b = y >> 8; const size_t rb = (size_t)b * TPB;
                Q = U + (rb + qb * 256) * NIN_E + h * 64; K = U + rb * NIN_E + 512 + h * 64; V = U + rb * NIN_E + 1024 + h * 64; O = MIX + (rb + qb * 256) * 1024 + h * 64;
                NT = 16; isna = true; na_qb = qb; na_h = h; }
            else if (id < 3136) { const int x = id - 3072, half = x & 1, comp = (x >> 1) & 1, hd = (x >> 2) & 3, b = x >> 4; const size_t rb = (size_t)b * TPB + SEQ;
                Q = U + rb * NIN_E + 1536 + (2 * hd + comp) * 64; K = U + rb * NIN_E + 2048 + (2 * hd + comp) * 64; V = U + rb * NIN_E + 2560 + hd * 128 + half * 64;
                O = DAO + rb * 1024 + ((hd * 2 + comp) * 2 + half) * 64; NT = 4; }
            else { const int x = id - 3136, h = x & 7, b = x >> 3; const size_t rb = (size_t)b * TPB + SEQ;
                Q = U + rb * NIN_E + h * 64; K = U + rb * NIN_E + 512 + h * 64; V = U + rb * NIN_E + 1024 + h * 64; O = MIX + rb * 1024 + h * 64; NT = 4; }
        } else {
            pin = NIN_O;
            if (id < 512) {
#ifndef NO_HYU
 hyena_unit(F, a, l, id, dry);
#endif
 continue; }
            else if (id < 1536) { const int y = id - 512, qb = y & 31, h = (y >> 5) & 7, b = y >> 8; const size_t rb = (size_t)b * TPB;
                Q = U + (rb + qb * 256) * NIN_O + h * 64; K = U + rb * NIN_O + 512 + (h >> 2) * 64; V = U + rb * NIN_O + 640 + (h >> 2) * 64; O = MIX + (rb + qb * 256) * 1024 + h * 64; }
            else if (id < 1568) { const int x = id - 1536, h = x & 7, b = x >> 3; const size_t rb = (size_t)b * TPB + SEQ;
                Q = U + rb * NIN_O + h * 64; K = U + rb * NIN_O + 512 + (h >> 2) * 64; V = U + rb * NIN_O + 640 + (h >> 2) * 64; O = MIX + rb * 1024 + h * 64; NT = 4; }
            else {
#ifndef NO_HYC
 hyena_ctx_item(F, a, l, id - 1568, U);
#endif
 continue; }
        }
        if (isna) {
            const float* rpb = a.in[lz + I_RPB] + ((size_t)i * 8 + na_h) * 465;
            { int t2 = F.tid; asm volatile("" : "+v"(t2)); if (t2 < 465) tab[t2] = rpb[t2] * 1.4426950408889634f; }
            NaMap tm; const int r4 = 4 * na_qb; tm.rlo = (r4 - 4 < 0) ? 0 : (r4 - 4 > 120 ? 120 : r4 - 4); tm.qr0 = r4; tm.tab = tab;
#ifndef NO_NA
            attn_body::attn_unit<8, NaMap>((const abf*)Q, pin, (const abf*)K, pin, (const abf*)V, pin, (abf*)O, po, NT, tm, ldsg, F0.wave0);
#endif
        } else {
            DenseMap tm;
#ifndef NO_DENSE
            attn_body::attn_unit<8, DenseMap>((const abf*)Q, pin, (const abf*)K, pin, (const abf*)V, pin, (abf*)O, po, NT, tm, ldsg, F0.wave0);
#endif
        }
    }
}

__device__ __forceinline__ void hypost_phase(Frame& F0, const Args& a, int l) {
    Frame F = F0; { int t_ = F0.wave0 * 64 + lane_asm(); asm volatile("" : "+v"(t_)); F.tid = t_; F.lane = t_ & 63; F.wave = __builtin_amdgcn_readfirstlane(t_ >> 6); } int lz = 0; asm volatile("" : "+s"(lz)); unsigned char* wsl = (unsigned char*)((unsigned long long)a.ws ^ (unsigned long long)(unsigned)lz);
    const bf16* YT = (const bf16*)(wsl + WS_X0T); const bf16* YTC = (const bf16*)(wsl + WS_YTC); bf16* MIX = (bf16*)(wsl + WS_H);
    LAS bf16* zs = (LAS bf16*)F.lds;
    const int ntile = 512 + (l == 1 ? 16 : 0);
    for (int it = F.bid; it < ntile * 4; it += F.G) {
        const int cgp = it & 3, tile = it >> 2;
        const bf16* src; size_t row0; int cstride;
        if (tile < 512) { const int b = tile >> 7, t0 = (tile & 127) * 64; src = YT + (size_t)b * SEQ + t0; cstride = NBATCH * SEQ; row0 = (size_t)b * TPB + t0; }
        else { const int x = tile - 512, b = x >> 2, t0 = (x & 3) * 64; src = YTC + b * 256 + t0; cstride = 1024; row0 = (size_t)b * TPB + SEQ + t0; }
        { const int c = F.tid >> 2, q = F.tid & 3; const bf16* sp = src + (size_t)(cgp * 128 + c) * cstride + q * 16;
          const v4u a0 = *(const v4u*)sp, a1 = *(const v4u*)(sp + 8); LAS unsigned* d = (LAS unsigned*)(zs + c * 66 + q * 16);
          d[0] = a0.x; d[1] = a0.y; d[2] = a0.z; d[3] = a0.w; d[4] = a1.x; d[5] = a1.y; d[6] = a1.z; d[7] = a1.w; }
        __syncthreads();
        { const int cp = F.tid & 63, tq = F.tid >> 6;
#pragma unroll
          for (int k = 0; k < 8; ++k) { const int t = tq * 8 + k; const unsigned lo = zs[(2 * cp) * 66 + t], hi = zs[(2 * cp + 1) * 66 + t];
              *(unsigned*)(MIX + (row0 + t) * 1024 + 512 + cgp * 128 + 2 * cp) = lo | (hi << 16); } }
        __syncthreads();
    }
}

__device__ __forceinline__ void dacombine_phase(Frame& F0, const Args& a, int l) {
    Frame F = F0; { int t_ = F0.wave0 * 64 + lane_asm(); asm volatile("" : "+v"(t_)); F.tid = t_; F.lane = t_ & 63; F.wave = __builtin_amdgcn_readfirstlane(t_ >> 6); } int lz = 0; asm volatile("" : "+s"(lz)); unsigned char* wsl = (unsigned char*)((unsigned long long)a.ws ^ (unsigned long long)(unsigned)lz);
    const int i = l >> 1; const float lam_init = 0.8f - 0.6f * expf(-0.3f * (float)l);
    const float s1 = wave_sum(a.in[lz + I_LQ1][i * 64 + F.lane] * a.in[lz + I_LK1][i * 64 + F.lane], F.lane), s2 = wave_sum(a.in[lz + I_LQ2][i * 64 + F.lane] * a.in[lz + I_LK2][i * 64 + F.lane], F.lane);
    const float lam = expf(s1) - expf(s2) + lam_init;
    const bf16* DAO = (const bf16*)(wsl + WS_DAO); bf16* MIX = (bf16*)(wsl + WS_H);
    const int hd = F.lane >> 4, d = (F.lane & 15) * 8, half = d >> 6, dd = d & 63;
    const float* sg = a.in[lz + I_SUBLN] + i * 128 + d;
    const f32x4 g0 = *(const f32x4*)sg, g1 = *(const f32x4*)(sg + 4);
    const float gg[8] = {g0.x, g0.y, g0.z, g0.w, g1.x, g1.y, g1.z, g1.w};
    const int gw = F.bid * NWAVES + F.wave, NGW = F.G * NWAVES;
    for (int row = gw; row < MROWS; row += 3 * NGW) {
        int rw[3]; bool ok[3]; v4u w1[3], w2[3];
#pragma unroll
        for (int q = 0; q < 3; ++q) { rw[q] = row + q * NGW; ok[q] = rw[q] < MROWS; if (!ok[q]) rw[q] = row;
            w1[q] = *(const v4u*)(DAO + (size_t)rw[q] * 1024 + ((hd * 2 + 0) * 2 + half) * 64 + dd); w2[q] = *(const v4u*)(DAO + (size_t)rw[q] * 1024 + ((hd * 2 + 1) * 2 + half) * 64 + dd); }
#pragma unroll
        for (int q = 0; q < 3; ++q) {
            float y[8] = {bflo(w1[q].x) - lam * bflo(w2[q].x), bfhi(w1[q].x) - lam * bfhi(w2[q].x), bflo(w1[q].y) - lam * bflo(w2[q].y), bfhi(w1[q].y) - lam * bfhi(w2[q].y),
                          bflo(w1[q].z) - lam * bflo(w2[q].z), bfhi(w1[q].z) - lam * bfhi(w2[q].z), bflo(w1[q].w) - lam * bflo(w2[q].w), bfhi(w1[q].w) - lam * bfhi(w2[q].w)};
            float ss = 0.f;
#pragma unroll
            for (int e = 0; e < 8; ++e) ss += y[e] * y[e];
            ss += shfl_l(ss, F.lane ^ 1); ss += shfl_l(ss, F.lane ^ 2); ss += shfl_l(ss, F.lane ^ 4); ss += shfl_l(ss, F.lane ^ 8);
            const float r = (1.0f / sqrtf(ss * (1.f / 128.f) + EPS)) * (1.f - lam_init);
            v4u o; o.x = pk2(y[0] * r * gg[0], y[1] * r * gg[1]); o.y = pk2(y[2] * r * gg[2], y[3] * r * gg[3]); o.z = pk2(y[4] * r * gg[4], y[5] * r * gg[5]); o.w = pk2(y[6] * r * gg[6], y[7] * r * gg[7]);
            if (ok[q]) *(v4u*)(MIX + (size_t)rw[q] * 1024 + 512 + F.lane * 8) = o;
        }
    }
}

__device__ __forceinline__ void convact_phase(Frame& F0, const Args& a, int l, int dry) {
    Frame F = F0; { int t_ = F0.wave0 * 64 + lane_asm(); asm volatile("" : "+v"(t_)); F.tid = t_; F.lane = t_ & 63; F.wave = __builtin_amdgcn_readfirstlane(t_ >> 6); } int lz = 0; asm volatile("" : "+s"(lz)); unsigned char* wsl = (unsigned char*)((unsigned long long)a.ws ^ (unsigned long long)(unsigned)lz);
    bf16* GV = (bf16*)(wsl + WS_GV);
    if (F.tid >= 352) return;
    const int j0 = F.tid * 8;
    const float* cw = a.in[lz + I_FCW] + (size_t)l * 3 * FFH + j0; const float* cb = a.in[lz + I_FCB] + (size_t)l * FFH + j0;
    float w0[8], w1[8], w2[8], bb[8];
#pragma unroll
    for (int e = 0; e < 8; ++e) { w0[e] = cw[e]; w1[e] = cw[FFH + e]; w2[e] = cw[2 * FFH + e]; bb[e] = cb[e]; }
    for (int it = F.bid; it < MROWS / 32; it += F.G) {
        const int r0 = it * 32, ts = r0 % TPB; const bool first = (ts == 0 || ts == SEQ), last = (ts + 32 == SEQ || ts + 32 == TPB);
#pragma unroll 1
        for (int rb = 0; rb < 32; rb += 8) {
            v4u gl[10], vl[8];
#pragma unroll
            for (int k = 0; k < 10; ++k) { const int r = rb - 1 + k; const bool zero = (r < 0 && first) || (r >= 32 && last);
                gl[k] = zero ? (v4u){0u, 0u, 0u, 0u} : *(const v4u*)(GV + (size_t)(r0 + r) * NUP + j0); }
#pragma unroll
            for (int k = 0; k < 8; ++k) vl[k] = *(const v4u*)(GV + (size_t)(r0 + rb + k) * NUP + FFH + j0);
#pragma unroll
            for (int k = 0; k < 8; ++k) {
                const unsigned gpa[4] = {gl[k].x, gl[k].y, gl[k].z, gl[k].w}, gca[4] = {gl[k + 1].x, gl[k + 1].y, gl[k + 1].z, gl[k + 1].w}, gna[4] = {gl[k + 2].x, gl[k + 2].y, gl[k + 2].z, gl[k + 2].w}, vva[4] = {vl[k].x, vl[k].y, vl[k].z, vl[k].w};
                unsigned oo[4];
#pragma unroll
                for (int q = 0; q < 4; ++q) {
                    const float ga = w0[2 * q] * bflo(gpa[q]) + w1[2 * q] * bflo(gca[q]) + w2[2 * q] * bflo(gna[q]) + bb[2 * q];
                    const float gb = w0[2 * q + 1] * bfhi(gpa[q]) + w1[2 * q + 1] * bfhi(gca[q]) + w2[2 * q + 1] * bfhi(gna[q]) + bb[2 * q + 1];
                    const float sa = ga / (1.f + __expf(-ga)), sb = gb / (1.f + __expf(-gb));
                    oo[q] = pk2(sa * bflo(vva[q]), sb * bfhi(vva[q])); }
                if (dry && oo[0] != 0x12345678u) { oo[0] = vva[0]; oo[1] = vva[1]; oo[2] = vva[2]; oo[3] = vva[3]; }
                *(v4u*)(GV + (size_t)(r0 + rb + k) * NUP + FFH + j0) = (v4u){oo[0], oo[1], oo[2], oo[3]};
            }
        }
    }
}
#ifdef PROBE_SYNC
#define GSYNC() do { xcd_barrier(xbar); xcd_barrier(xbar); } while (0)
#else
#define GSYNC() xcd_barrier(xbar)
#endif
#define GSYNC_CG() do { asm volatile("s_waitcnt vmcnt(0) lgkmcnt(0)" ::: "memory"); grid.sync(); __builtin_amdgcn_fence(__ATOMIC_ACQUIRE, "agent"); } while (0)
#if defined(NO_GEMM) || defined(NO_GEMM1)
#define GEMMCALL1 if (0)
#else
#define GEMMCALL1
#endif
#if defined(NO_GEMM) || defined(NO_GEMM2)
#define GEMMCALL2 if (0)
#else
#define GEMMCALL2
#endif
#if defined(NO_GEMM) || defined(NO_GEMM3)
#define GEMMCALL3 if (0)
#else
#define GEMMCALL3
#endif
#if defined(NO_GEMM) || defined(NO_GEMM4)
#define GEMMCALL4 if (0)
#else
#define GEMMCALL4
#endif
__global__ void __launch_bounds__(NTHREADS, 2) hybrid_fwd(Args a) {
    extern __shared__ __attribute__((aligned(16))) unsigned char lds[];
    cg::grid_group grid = cg::this_grid();
    Frame F;
    F.lds = (LAS unsigned char*)lds; F.tid = threadIdx.x; F.lane = F.tid & 63; F.wave = __builtin_amdgcn_readfirstlane(F.tid >> 6); F.G = gridDim.x; F.bid = blockIdx.x; F.wave0 = F.wave;

    { volatile LAS unsigned* misc = (volatile LAS unsigned*)(F.lds + MISC_OFF); if (F.tid < 32) misc[F.tid] = 0u; }
    __syncthreads();
    XcdBarrier xbar = xcd_barrier_post((unsigned*)(a.ws + WS_CTL) + CW_BAR, (volatile LAS unsigned*)(F.lds + MISC_OFF) + 8);
#ifndef NO_P0
    p0_prologue(F, a);
#endif
#ifdef PROBE_P0
    __syncthreads(); p0_prologue(F, a);
#endif

    { int never = 0; asm volatile("" : "+s"(never)); if (never) GSYNC_CG(); }
    GSYNC();
#define SITE() int lz = 0; asm volatile("" : "+s"(lz)); unsigned char* ws = (unsigned char*)((unsigned long long)a.ws ^ (unsigned long long)(unsigned)lz); (void)ws; \
    int bidl = F.bid; asm volatile("" : "+s"(bidl)); (void)bidl; \
    float* MODS = (float*)(ws + WS_MODS); float* XC = (float*)(ws + WS_XC); bf16* H = (bf16*)(ws + WS_H); bf16* U = (bf16*)(ws + WS_U); bf16* GV = (bf16*)(ws + WS_GV); \
    const float* xl_src = l == 0 ? a.in[lz + I_X] : a.out; const float* xc_src = l == 0 ? a.in[lz + I_CTX] : XC; const float* mods_l = MODS + (size_t)l * 5 * 6144; \
    (void)H; (void)U; (void)GV; (void)xl_src; (void)xc_src; (void)mods_l
#pragma nounroll
    for (int l = 0; l < 4; ++l) {
        const int even = !(l & 1);
        { SITE(); norm_phase(F, xl_src, xc_src, mods_l, 0, H); }
        weights_phase(F, a, l);
        __syncthreads();
        if (!even) filter_phase(F, a, l);
#ifdef PROBE_FILT
        if (!even) { __syncthreads(); filter_phase(F, a, l); }
#endif
        GSYNC();
        { SITE(); const int nin = even ? NIN_E : NIN_O; pg8::Gemm g{H, 1024, (const bf16*)(ws + WS_WIN), MROWS, nin, 1024}; pg8::StaticOrder S; S.init(MROWS, nin, F.G, bidl, even);
          EpiStore E{U, nin}; pg8::gemm_phase<EpiStore, pg8::StaticOrder, true, true>(F.lds, g, S, E, F.wave0);
          if (even) ctx_strip_gemm(F, H, 1024, (const bf16*)(ws + WS_WIN), 1024, nullptr, nullptr, nullptr, NIN_E / 64, U, NIN_E); }
        GSYNC();
#ifdef PROBE_QKN
        { SITE(); qknorm_phase(F, a, l, U, 1); }
#endif
        { SITE(); qknorm_phase(F, a, l, U); if (!even) hyprep_phase(F, a, l, U); }
        GSYNC();
#ifdef PROBE_MIXO
        for (int rep = 0; rep < (even ? 1 : 2); ++rep) { mixer_phase(F, a, l, (char*)lds, l + 4 * rep, (!even && rep == 0) ? 1 : 0); GSYNC(); }
#else
        mixer_phase(F, a, l, (char*)lds, l, 0);
        GSYNC();
#endif
        if (even) dacombine_phase(F, a, l); else hypost_phase(F, a, l);
        GSYNC();
        { SITE(); pg8::Gemm g{H, 1024, (const bf16*)(ws + WS_WOUT), MROWS, 1024, 1024}; pg8::StaticOrder S; S.init(MROWS, 1024, F.G, bidl, 1);
          EpiResid E{xl_src, xc_src, a.out, XC, mods_l + 2048};
#ifdef PROBE_GEMM2
          for (int rep = 0; rep < 2; ++rep) { int zi = rep; asm volatile("" : "+s"(zi)); E.mul = (float)zi; if (rep == 0) { E.dl = (float*)xl_src; E.dc = (float*)xc_src; } else { E.dl = a.out; E.dc = XC; } pg8::gemm_phase<EpiResid, pg8::StaticOrder, true, true>(F.lds, g, S, E, F.wave0); if (rep == 0) GSYNC(); }
#else
          pg8::gemm_phase<EpiResid, pg8::StaticOrder, true, true>(F.lds, g, S, E, F.wave0);
#endif
          if (l < 3) ctx_strip_gemm(F, H, 1024, (const bf16*)(ws + WS_WOUT), 1024, xc_src, XC, mods_l + 4 * 6144 + 2048); }
        GSYNC();
        { SITE(); norm_phase(F, a.out, XC, mods_l, 3072, H); }
        GSYNC();
        { SITE(); pg8::Gemm g{H - 1024, 1024, (const bf16*)(ws + WS_WUP), 137 * 256, NUP, 1024, 1}; pg8::StaticOrder S; S.init(137 * 256, NUP, F.G, bidl);
          EpiConv E{GV, a.in[lz + I_FCW] + (size_t)l * 3 * FFH, a.in[lz + I_FCB] + (size_t)l * FFH}; pg8::gemm_phase<EpiConv, pg8::StaticOrder, true, true>(F.lds, g, S, E, F.wave0); }
        GSYNC();
        { SITE(); pg8::Gemm g{GV, FFH, (const bf16*)(ws + WS_WDOWN), MROWS, 1024, FFH}; pg8::StaticOrder S; S.init(MROWS, 1024, F.G, bidl, 1);
          EpiResid E{a.out, XC, a.out, XC, mods_l + 5120};
#ifdef PROBE_GEMM2
          for (int rep = 0; rep < 2; ++rep) { int zi = rep; asm volatile("" : "+s"(zi)); E.mul = (float)zi; pg8::gemm_phase<EpiResid, pg8::StaticOrder, true, true>(F.lds, g, S, E, F.wave0); if (rep == 0) GSYNC(); }
#else
          pg8::gemm_phase<EpiResid, pg8::StaticOrder, true, true>(F.lds, g, S, E, F.wave0);
#endif
          if (l < 3) ctx_strip_gemm(F, GV, FFH, (const bf16*)(ws + WS_WDOWN), FFH, XC, XC, mods_l + 4 * 6144 + 5120); }
        GSYNC();
    }
}

extern "C" void kernel_launch(void* const* d_in, const int* in_sizes, int n_in, void* d_out, int out_size, void* d_ws, size_t ws_size, hipStream_t stream) {
    static int grid = 0;
    if (grid == 0) {
        if (n_in != 37 || out_size != NBATCH * SEQ * DMODEL || ws_size < WS_END) { fprintf(stderr, "kernel_launch: unexpected problem (n_in %d out %d ws %zu)\n", n_in, out_size, ws_size); grid = -1; return; }
        int dev = 0, cus = 0, per_cu = 0;
        if (hipGetDevice(&dev) != hipSuccess || hipDeviceGetAttribute(&cus, hipDeviceAttributeMultiprocessorCount, dev) != hipSuccess) { grid = -1; return; }
        if (hipFuncSetAttribute((const void*)hybrid_fwd, hipFuncAttributeMaxDynamicSharedMemorySize, LDS_BYTES) != hipSuccess) { fprintf(stderr, "kernel_launch: hipFuncSetAttribute failed\n"); grid = -1; return; }
        if (hipOccupancyMaxActiveBlocksPerMultiprocessor(&per_cu, (const void*)hybrid_fwd, NTHREADS, LDS_BYTES) != hipSuccess || per_cu < 1) { fprintf(stderr, "kernel_launch: occupancy query says %d\n", per_cu); }
        (void)hipGetLastError();
        grid = cus;
    }
    if (grid < 0) return;
    if (hipMemsetAsync((char*)d_ws + WS_CTL, 0, CTL_ZERO_BYTES, stream) != hipSuccess) { fprintf(stderr, "kernel_launch: memset failed\n"); return; }
    Args a{};
    for (int i = 0; i < 37; ++i) a.in[i] = (const float*)d_in[i];
    a.out = (float*)d_out; a.ws = (unsigned char*)d_ws;
    void* args[] = {&a};
    hipError_t e = hipLaunchCooperativeKernel((const void*)hybrid_fwd, dim3(grid), dim3(NTHREADS), args, LDS_BYTES, stream);
    if (e != hipSuccess) fprintf(stderr, "kernel_launch: cooperative launch failed: %s (grid %d)\n", hipGetErrorString(e), grid);
}
```

```cpp
#include <hip/hip_runtime.h>
#include <hip/hip_cooperative_groups.h>
#include <hip/hip_bf16.h>
#include <cstdio>
#include <cstdint>
#include <cmath>
namespace cg = cooperative_groups;
__device__ __forceinline__ int lane_asm() { int x; asm volatile("v_mbcnt_lo_u32_b32 %0, -1, 0\n\tv_mbcnt_hi_u32_b32 %0, -1, %0" : "=v"(x)); return x; }
__device__ __forceinline__ float shfl_l(float v, int srclane) { return __builtin_bit_cast(float, __builtin_amdgcn_ds_bpermute(srclane << 2, __builtin_bit_cast(int, v))); }
namespace pg8 {
#define PG8_LAS __attribute__((address_space(3)))
typedef unsigned short bf16_t;
typedef short bf16x8 __attribute__((ext_vector_type(8)));
typedef float f32x4 __attribute__((ext_vector_type(4)));
typedef unsigned u32x4 __attribute__((ext_vector_type(4)));
constexpr int BM = 256, BK = 64, HALF = 128, HTB = HALF * BK * 2  , STAGE_BYTES = 8 * HTB, NXCD = 8, WGM = 8;

__host__ __device__ __forceinline__ int lds_byte(int r, int c) { const int st = (r >> 4) * 2 + (c >> 5), rr = r & 15, cc = c & 31, ob = rr * 64 + cc * 2; return st * 1024 + (ob ^ (((ob >> 9) & 1) << 5)); }
__host__ __device__ __forceinline__ void stage_rc(int b, int& R, int& C) { const int st = b / 1024, sb = b % 1024, swz = sb ^ (((sb >> 9) & 1) << 5); R = (st >> 1) * 16 + swz / 64; C = (st & 1) * 32 + (swz % 64) / 2; }
__host__ __device__ __forceinline__ int perm32(int rho) { const int n = rho >> 4, i = rho & 15; return 8 * (i >> 2) + 4 * n + (i & 3); }

struct Unit { int pm, pn; };
struct Gemm { const bf16_t* A; int lda; const bf16_t* Bt; int M, N, K; int ov = 0; };

struct StaticOrder {
    int nM, nN, nwg, G, c, skip;
    __host__ __device__ void init(int M, int N, int G_, int c_, int skip_ = 0) { nM = skip_ ? 128 : M / BM; nN = N / BM; nwg = nM * nN; G = G_; c = c_; skip = skip_; }
    __host__ __device__ bool next(int i, Unit& u) const {
        const long L = (long)i * G + c; if (L >= nwg) return false;
        int wgid = (int)L; { const int q = nwg / NXCD, r = nwg % NXCD, xcd = wgid % NXCD, off = wgid / NXCD; wgid = (xcd < r ? xcd * (q + 1) : r * (q + 1) + (xcd - r) * q) + off; }
        const int nig = WGM * nN, gid = wgid / nig, fm = gid * WGM, gsz = (nM - fm) < WGM ? (nM - fm) : WGM;
        u.pm = fm + ((wgid % nig) % gsz); u.pn = (wgid % nig) / gsz; if (skip) u.pm += u.pm >> 5; return true;
    }
    __device__ __forceinline__ void a_ready(const Unit&) const {}
    __device__ __forceinline__ void done(const Unit&) const {}
};

__device__ __forceinline__ unsigned cvt_pk_bf16(float lo, float hi) { unsigned r; asm volatile("v_cvt_pk_bf16_f32 %0, %1, %2" : "=v"(r) : "v"(lo), "v"(hi)); return r; }
typedef float f32x2 __attribute__((ext_vector_type(2)));
__device__ __forceinline__ f32x2 gelu_pk(f32x2 v) {
    const f32x2 av = __builtin_elementwise_abs(v), d = av * 0.2316418882f + 1.0f;
    f32x2 t; t.x = __builtin_amdgcn_rcpf(d.x); t.y = __builtin_amdgcn_rcpf(d.y);
    f32x2 q = t * 0.5307027145f + (-0.7265760135f); q = q * t + 0.7107068705f; q = q * t + (-0.142248368f); q = q * t + 0.127414796f; q = q * t;
    const f32x2 s = (v * v) * (-0.72134752044f);
    f32x2 e; e.x = __builtin_amdgcn_exp2f(s.x); e.y = __builtin_amdgcn_exp2f(s.y);
    const f32x2 m = v * (q * e), r = v - m;
    f32x2 o; o.x = v.x < 0.f ? m.x : r.x; o.y = v.y < 0.f ? m.y : r.y; return o;
}

template <int ACT  > struct EpiBf16 {
    static constexpr bool PERM = true, AFTER_DRAIN = false; static_assert(ACT == 0 || ACT == 1, "EpiBf16: ACT is 0 (none) or 1 (gelu_pk)");
    bf16_t* O; int ldc; const float* bias; int split_cols; size_t split_stride; float scale0;
    __device__ __forceinline__ void operator()(const f32x4 (&acc)[2][2][4][2], const Unit& u, int wr, int wc, int fr, int fq) const {
        const int row0 = u.pm * BM + wr * 64 + fr; int colt = u.pn * BM; bf16_t* base = O;
        float sc = 1.f; if (split_cols) { const int t = colt / split_cols; base += (size_t)t * split_stride; colt -= t * split_cols; if (t == 0) sc = scale0; }
        const int col0 = colt + wc * 32 + 8 * fq, bcol0 = u.pn * BM + wc * 32 + 8 * fq;
        f32x4 bv[2][2];
#pragma unroll
        for (int bj = 0; bj < 2; ++bj)
#pragma unroll
            for (int n = 0; n < 2; ++n) bv[bj][n] = bias ? *(const f32x4*)(bias + bcol0 + bj * HALF + 4 * n) : (f32x4){0.f, 0.f, 0.f, 0.f};
#pragma unroll
        for (int ai = 0; ai < 2; ++ai)
#pragma unroll
            for (int m = 0; m < 4; ++m) { bf16_t* rowp = base + (size_t)(row0 + ai * HALF + m * 16) * ldc + col0;
#pragma unroll
                for (int bj = 0; bj < 2; ++bj) { f32x4 v0 = acc[ai][bj][m][0] + bv[bj][0], v1 = acc[ai][bj][m][1] + bv[bj][1];
                    if (ACT == 1) { f32x2 a = gelu_pk((f32x2){v0[0], v0[1]}), b = gelu_pk((f32x2){v0[2], v0[3]}), c = gelu_pk((f32x2){v1[0], v1[1]}), d = gelu_pk((f32x2){v1[2], v1[3]});
                        v0 = (f32x4){a.x, a.y, b.x, b.y}; v1 = (f32x4){c.x, c.y, d.x, d.y}; }
                    v0 = v0 * sc; v1 = v1 * sc; u32x4 w; w.x = cvt_pk_bf16(v0[0], v0[1]); w.y = cvt_pk_bf16(v0[2], v0[3]); w.z = cvt_pk_bf16(v1[0], v1[1]); w.w = cvt_pk_bf16(v1[2], v1[3]);
                    *(u32x4*)(rowp + bj * HALF) = w; } }
    }
};
template <class Epi, class Sched, bool ALIGN_EPI = false, bool SP2 = false>
__device__ __forceinline__ void gemm_phase(PG8_LAS unsigned char* lds, const Gemm g, const Sched& S, const Epi& E, int wave0) {
    int tid_ = wave0 * 64 + lane_asm(); asm volatile("" : "+v"(tid_)); const int tid = tid_, wid = __builtin_amdgcn_readfirstlane(tid >> 6), lane = tid & 63, wr = wid >> 2, wc = wid & 3, fr = lane & 15, fq = lane >> 4;
    const int K = g.K, nt = K / BK;
    unsigned voffA[2], voffB[2];
#pragma unroll
    for (int i = 0; i < 2; ++i) { int R, C; stage_rc(tid * 16 + i * 8192, R, C); const int Rb = Epi::PERM ? ((R & ~31) + perm32(R & 31)) : R;
        voffA[i] = (unsigned)((g.ov ? R - 2 * (R >> 6) : R) * g.lda + C) * 2u; voffB[i] = (unsigned)(Rb * K + C) * 2u; }
    const size_t kstep = (size_t)(BK * 2);
    const size_t hstepA = (size_t)(g.ov ? 124 : HALF) * g.lda * 2, hstepB = (size_t)HALF * K * 2;
    const size_t tstepA = 2 * hstepA, tstepB = 2 * hstepB;
    const unsigned ldsw = (unsigned)wid * 1024u;
    const int aoff = lds_byte(wr * 64 + fr, fq * 8), boff = lds_byte(wc * 32 + fr, fq * 8);
#define PG8_SA(b, h) (((b) * 2 + (h)) * HTB)
#define PG8_SB(b, h) ((4 + (b) * 2 + (h)) * HTB)
#define PG8_STAGE(bufoff, gbase, voff) do { _Pragma("unroll") for (int _i = 0; _i < 2; ++_i) \
        __builtin_amdgcn_global_load_lds((const unsigned*)((const char*)(gbase) + (voff)[_i]), (PG8_LAS unsigned*)(lds + (bufoff) + ldsw + _i * 8192), 16, 0, 0); } while (0)
#define PG8_LDA(dst, b, h) do { _Pragma("unroll") for (int m = 0; m < 4; ++m) _Pragma("unroll") for (int k = 0; k < 2; ++k) dst[m][k] = *(const PG8_LAS bf16x8*)(lds + PG8_SA(b, h) + aoff + m * 2048 + k * 1024); } while (0)
#define PG8_LDB(dst, b, h) do { _Pragma("unroll") for (int n = 0; n < 2; ++n) _Pragma("unroll") for (int k = 0; k < 2; ++k) dst[n][k] = *(const PG8_LAS bf16x8*)(lds + PG8_SB(b, h) + boff + n * 2048 + k * 1024); } while (0)
#define PG8_MMA(ai, bj, At, Bt) do { __builtin_amdgcn_s_setprio(1); _Pragma("unroll") for (int m = 0; m < 4; ++m) _Pragma("unroll") for (int n = 0; n < 2; ++n) _Pragma("unroll") for (int k = 0; k < 2; ++k) \
        acc[ai][bj][m][n] = __builtin_amdgcn_mfma_f32_16x16x32_bf16(Bt[n][k], At[m][k], acc[ai][bj][m][n], 0, 0, 0); __builtin_amdgcn_s_setprio(0); } while (0)
#define PG8_WAIT_V(n) asm volatile("s_waitcnt vmcnt(" #n ")" ::: "memory")
#define PG8_WAIT_L(n) asm volatile("s_waitcnt lgkmcnt(" #n ")" ::: "memory")
#define PG8_BAR __builtin_amdgcn_s_barrier()
#define PG8_SCHED __builtin_amdgcn_sched_barrier(0)
    Unit cur, nxt; int ui = 0;
    if (!S.next(0, cur)) return;
    f32x4 acc[2][2][4][2];
#pragma unroll
    for (int a = 0; a < 2; ++a)
#pragma unroll
        for (int b = 0; b < 2; ++b)
#pragma unroll
            for (int m = 0; m < 4; ++m)
#pragma unroll
                for (int n = 0; n < 2; ++n) acc[a][b][m][n] = (f32x4){0.f, 0.f, 0.f, 0.f};
    bf16x8 At[4][2], B0[2][2], B1[2][2];
    const char* cA = (const char*)g.A + (size_t)cur.pm * tstepA; const char* cB = (const char*)g.Bt + (size_t)cur.pn * tstepB;
    S.a_ready(cur);
    if constexpr (SP2) {
        PG8_STAGE(PG8_SB(0, 0), cB, voffB); PG8_STAGE(PG8_SB(0, 1), cB + hstepB, voffB); PG8_STAGE(PG8_SA(0, 0), cA, voffA); PG8_STAGE(PG8_SA(0, 1), cA + hstepA, voffA);
        if (wr == 1) PG8_BAR;
        PG8_WAIT_V(2); PG8_BAR;
        PG8_STAGE(PG8_SB(1, 0), cB + kstep, voffB); PG8_STAGE(PG8_SA(1, 0), cA + kstep, voffA); PG8_STAGE(PG8_SB(1, 1), cB + hstepB + kstep, voffB);
        PG8_WAIT_V(6); PG8_BAR;
    } else {
        PG8_STAGE(PG8_SB(0, 0), cB, voffB); PG8_STAGE(PG8_SA(0, 0), cA, voffA); PG8_STAGE(PG8_SB(0, 1), cB + hstepB, voffB); PG8_STAGE(PG8_SA(0, 1), cA + hstepA, voffA);
        if (wr == 1) PG8_BAR;
        PG8_WAIT_V(4); PG8_BAR;
        PG8_STAGE(PG8_SB(1, 0), cB + kstep, voffB); PG8_STAGE(PG8_SA(1, 0), cA + kstep, voffA); PG8_STAGE(PG8_SB(1, 1), cB + hstepB + kstep, voffB);
        PG8_WAIT_V(6); PG8_BAR;
    }
    for (;;) {
        const bool has_next = S.next(ui + 1, nxt);
        const char* nA = has_next ? (const char*)g.A + (size_t)nxt.pm * tstepA : cA; const char* nB = has_next ? (const char*)g.Bt + (size_t)nxt.pn * tstepB : cB;
        for (int t = 0; t < nt; t += 2) {
            const bool last = (t == nt - 2);
            const char* a1 = cA + (size_t)(t + 1) * kstep;
            const char* a2 = last ? nA : cA + (size_t)(t + 2) * kstep; const char* b2 = last ? nB : cB + (size_t)(t + 2) * kstep;
            const char* a3 = a2 + kstep; const char* b3 = b2 + kstep;
            if (last && has_next) S.a_ready(nxt);
            if constexpr (SP2) {
            PG8_LDB(B0, 0, 0); PG8_LDB(B1, 0, 1); PG8_SCHED; PG8_LDA(At, 0, 0); PG8_STAGE(PG8_SA(1, 1), a1 + hstepA, voffA);
            PG8_WAIT_V(8); PG8_WAIT_L(0); PG8_BAR; PG8_MMA(0, 0, At, B0); PG8_MMA(0, 1, At, B1); PG8_BAR; PG8_SCHED;
            PG8_LDA(At, 0, 1); PG8_STAGE(PG8_SB(0, 0), b2, voffB); PG8_STAGE(PG8_SB(0, 1), b2 + hstepB, voffB); PG8_STAGE(PG8_SA(0, 0), a2, voffA);
            PG8_WAIT_V(8); PG8_WAIT_L(0); PG8_BAR; PG8_MMA(1, 0, At, B0); PG8_MMA(1, 1, At, B1); PG8_BAR; PG8_SCHED;
            PG8_LDB(B0, 1, 0); PG8_LDB(B1, 1, 1); PG8_SCHED; PG8_LDA(At, 1, 0); PG8_STAGE(PG8_SA(0, 1), a2 + hstepA, voffA);
            PG8_WAIT_V(8); PG8_WAIT_L(0); PG8_BAR; PG8_MMA(0, 0, At, B0); PG8_MMA(0, 1, At, B1); PG8_BAR; PG8_SCHED;
            PG8_LDA(At, 1, 1); PG8_STAGE(PG8_SB(1, 0), b3, voffB); PG8_STAGE(PG8_SB(1, 1), b3 + hstepB, voffB); PG8_STAGE(PG8_SA(1, 0), a3, voffA);
            PG8_WAIT_V(8); PG8_WAIT_L(0); PG8_BAR; PG8_MMA(1, 0, At, B0); PG8_MMA(1, 1, At, B1); PG8_BAR; PG8_SCHED;
            } else {
            PG8_LDB(B0, 0, 0); PG8_SCHED; PG8_LDA(At, 0, 0); PG8_STAGE(PG8_SA(1, 1), a1 + hstepA, voffA);
            PG8_WAIT_L(8); PG8_BAR; PG8_WAIT_L(0); PG8_MMA(0, 0, At, B0); PG8_BAR; PG8_SCHED;
            PG8_LDB(B1, 0, 1); PG8_STAGE(PG8_SB(0, 0), b2, voffB);
            PG8_BAR; PG8_WAIT_L(0); PG8_MMA(0, 1, At, B1); PG8_BAR;
            PG8_LDA(At, 0, 1); PG8_STAGE(PG8_SA(0, 0), a2, voffA);
            PG8_BAR; PG8_WAIT_L(0); PG8_MMA(1, 0, At, B0); PG8_BAR; PG8_SCHED;
            PG8_STAGE(PG8_SB(0, 1), b2 + hstepB, voffB);
            PG8_WAIT_V(6); PG8_BAR; PG8_MMA(1, 1, At, B1); PG8_BAR;
            PG8_LDB(B0, 1, 0); PG8_SCHED; PG8_LDA(At, 1, 0); PG8_STAGE(PG8_SA(0, 1), a2 + hstepA, voffA);
            PG8_WAIT_L(8); PG8_BAR; PG8_WAIT_L(0); PG8_MMA(0, 0, At, B0); PG8_BAR; PG8_SCHED;
            PG8_LDB(B1, 1, 1); PG8_STAGE(PG8_SB(1, 0), b3, voffB);
            PG8_BAR; PG8_WAIT_L(0); PG8_MMA(0, 1, At, B1); PG8_BAR;
            PG8_LDA(At, 1, 1); PG8_STAGE(PG8_SA(1, 0), a3, voffA);
            PG8_BAR; PG8_WAIT_L(0); PG8_MMA(1, 0, At, B0); PG8_BAR; PG8_SCHED;
            PG8_STAGE(PG8_SB(1, 1), b3 + hstepB, voffB);
            PG8_WAIT_V(6); PG8_BAR; PG8_MMA(1, 1, At, B1); PG8_BAR;
            }
        }
        if constexpr (ALIGN_EPI) { if (wr == 0) PG8_BAR; }
        if constexpr (!Epi::AFTER_DRAIN) { E(acc, cur, wr, wc, fr, fq); S.done(cur); }
        if (!has_next) break;
#pragma unroll
        for (int a = 0; a < 2; ++a)
#pragma unroll
            for (int b = 0; b < 2; ++b)
#pragma unroll
                for (int m = 0; m < 4; ++m)
#pragma unroll
                    for (int n = 0; n < 2; ++n) acc[a][b][m][n] = (f32x4){0.f, 0.f, 0.f, 0.f};
        cur = nxt; cA = nA; cB = nB; ++ui;
        if constexpr (ALIGN_EPI) { if (wr == 1) PG8_BAR; }
    }
    PG8_WAIT_V(0);
    if constexpr (!ALIGN_EPI) { if (wr == 0) PG8_BAR; }
    PG8_BAR;
    if constexpr (Epi::AFTER_DRAIN) { E.fused(acc, cur, wr, wc, fr, fq, lds, wid, lane); S.done(cur); }
#undef PG8_SA
#undef PG8_SB
#undef PG8_STAGE
#undef PG8_LDA
#undef PG8_LDB
#undef PG8_MMA
#undef PG8_WAIT_V
#undef PG8_WAIT_L
#undef PG8_BAR
#undef PG8_SCHED
}
}
#include <hip/hip_bf16.h>
namespace attn_body {
using bf16=__hip_bfloat16;
using bf16x8=__attribute__((ext_vector_type(8)))short;
using s16x4=__attribute__((ext_vector_type(4)))short;
using f32x16=__attribute__((ext_vector_type(16)))float;
using u32x4=__attribute__((ext_vector_type(4)))unsigned;
constexpr int D=64;
constexpr int NW=8,QBLK=32,QB=QBLK*NW,KVBLK=64;
__device__ __forceinline__ int crow(int r,int hi){return (r&3)+8*(r>>2)+4*hi;}
#define SBAR() __builtin_amdgcn_sched_barrier(0)
constexpr int NSLOT=3, SLOTB=8192;
constexpr int LDS_K=0, LDS_V=NSLOT*SLOTB, LDS_WS=2*NSLOT*SLOTB, LDS_OST=LDS_WS+NW*64*4, LDS_BYTES=LDS_OST+NW*4096;
constexpr float C2=0.125f*1.4426950408889634f;
__device__ __forceinline__ void glds16(const void*gsrc,unsigned lds_dst){unsigned keep;
  asm volatile("s_mov_b32 %0, m0\n\ts_mov_b32 m0, %2\n\ts_nop 0\n\tglobal_load_lds_dwordx4 %1, off\n\ts_mov_b32 m0, %0":"=&s"(keep):"v"(gsrc),"s"(lds_dst):"memory");}
__device__ __forceinline__ float max3f(float a,float b,float c){float r;asm("v_max3_f32 %0, %1, %2, %3":"=v"(r):"v"(a),"v"(b),"v"(c));return r;}
__device__ __forceinline__ float max2f(float a,float b){float r;asm("v_max_f32_e32 %0, %1, %2":"=v"(r):"v"(a),"v"(b));return r;}
__device__ __forceinline__ float fadd_s(float a,float b){float r;asm("v_add_f32_e32 %0, %1, %2":"=v"(r):"v"(a),"v"(b));return r;}
__device__ __forceinline__ float fsub_s(float a,float b){float r;asm("v_sub_f32_e32 %0, %1, %2":"=v"(r):"v"(a),"v"(b));return r;}
typedef float f32x2_t __attribute__((ext_vector_type(2))); typedef __bf16 bf16x2_t __attribute__((ext_vector_type(2)));
__device__ __forceinline__ unsigned cvtpk_s(float lo,float hi){f32x2_t v={lo,hi};bf16x2_t b=__builtin_convertvector(v,bf16x2_t);return __builtin_bit_cast(unsigned,b);}
#define WAIT_BAR(N) asm volatile("s_waitcnt vmcnt(" #N ") lgkmcnt(0)\n\ts_barrier":::"memory")

__device__ __forceinline__ void qkt(f32x16&p0,f32x16&p1,const char*Kslot,const bf16x8*qr,const f32x16&negm,int r32,int hi){
  const char*kb=Kslot+hi*1024+r32*16;
  #pragma unroll
  for(int d0=0;d0<4;++d0){
    const bf16x8 b0=*reinterpret_cast<const bf16x8*>(kb+d0*2048);
    const bf16x8 b1=*reinterpret_cast<const bf16x8*>(kb+d0*2048+512);
    if(d0==0){p0=__builtin_amdgcn_mfma_f32_32x32x16_bf16(b0,qr[0],negm,0,0,0);p1=__builtin_amdgcn_mfma_f32_32x32x16_bf16(b1,qr[0],negm,0,0,0);}
    else{p0=__builtin_amdgcn_mfma_f32_32x32x16_bf16(b0,qr[d0],p0,0,0,0);p1=__builtin_amdgcn_mfma_f32_32x32x16_bf16(b1,qr[d0],p1,0,0,0);}}
}
typedef __attribute__((address_space(3))) const char* lds_cptr;
typedef short v4i16_t __attribute__((ext_vector_type(4)));
__device__ __forceinline__ void kload8(bf16x8*kf,lds_cptr kp){
  kf[0]=*(const __attribute__((address_space(3))) bf16x8*)(kp);      kf[1]=*(const __attribute__((address_space(3))) bf16x8*)(kp+512);
  kf[2]=*(const __attribute__((address_space(3))) bf16x8*)(kp+2048); kf[3]=*(const __attribute__((address_space(3))) bf16x8*)(kp+2560);
  kf[4]=*(const __attribute__((address_space(3))) bf16x8*)(kp+4096); kf[5]=*(const __attribute__((address_space(3))) bf16x8*)(kp+4608);
  kf[6]=*(const __attribute__((address_space(3))) bf16x8*)(kp+6144); kf[7]=*(const __attribute__((address_space(3))) bf16x8*)(kp+6656);
}
__device__ __forceinline__ void kload2(bf16x8*kf,lds_cptr kp,int j){ kf[2*j]=*(const __attribute__((address_space(3))) bf16x8*)(kp+j*2048); kf[2*j+1]=*(const __attribute__((address_space(3))) bf16x8*)(kp+j*2048+512); }
__device__ __forceinline__ s16x4 vtr(lds_cptr p){ return __builtin_bit_cast(s16x4,__builtin_amdgcn_ds_read_tr16_b64_v4i16((__attribute__((address_space(3))) v4i16_t*)p)); }
__device__ __forceinline__ float rowmax(const f32x16&p0,const f32x16&p1){
  float a=max3f(p0[0],p0[1],p1[0]),b=max3f(p0[2],p0[3],p1[1]);a=max3f(a,p1[2],p1[3]);
  #pragma unroll
  for(int r=4;r<16;r+=4){a=max3f(a,p0[r],p0[r+1]);b=max3f(b,p0[r+2],p0[r+3]);a=max3f(a,p1[r],p1[r+1]);b=max3f(b,p1[r+2],p1[r+3]);}
  const float m=max2f(a,b);
  auto rr=__builtin_amdgcn_permlane32_swap(__float_as_uint(m),__float_as_uint(m),false,false);
  return max2f(__uint_as_float(rr[0]),__uint_as_float(rr[1]));
}
__device__ __forceinline__ void pv(f32x16*o,int vb,bf16x8 pa0,bf16x8 pa1,bf16x8 pa2,bf16x8 pa3){
  #pragma unroll
  for(int d0=0;d0<2;++d0){s16x4 lo[4],hi[4];
    #pragma unroll
    for(int ks=0;ks<4;++ks){
      asm volatile("ds_read_b64_tr_b16 %0,%1 offset:%c2":"=&v"(lo[ks]):"v"(vb),"i"(d0*4096+ks*1024):"memory");
      asm volatile("ds_read_b64_tr_b16 %0,%1 offset:%c2":"=&v"(hi[ks]):"v"(vb),"i"(d0*4096+ks*1024+512):"memory");}
    asm volatile("s_waitcnt lgkmcnt(0)":::"memory");SBAR();
    #define PK(k) (bf16x8){lo[k][0],lo[k][1],lo[k][2],lo[k][3],hi[k][0],hi[k][1],hi[k][2],hi[k][3]}
    o[d0]=__builtin_amdgcn_mfma_f32_32x32x16_bf16(pa0,PK(0),o[d0],0,0,0);
    o[d0]=__builtin_amdgcn_mfma_f32_32x32x16_bf16(pa1,PK(1),o[d0],0,0,0);
    o[d0]=__builtin_amdgcn_mfma_f32_32x32x16_bf16(pa2,PK(2),o[d0],0,0,0);
    o[d0]=__builtin_amdgcn_mfma_f32_32x32x16_bf16(pa3,PK(3),o[d0],0,0,0);
    #undef PK
  }
}

#ifndef ATTN_STORE16
#define ATTN_STORE16(p,v) (*(u32x4*)(p)=(v))
#endif
template<int THRL,class TM> __device__ __forceinline__ void attn_unit(const bf16*Q,int ptq,const bf16*__restrict__ K,int ptk,const bf16*__restrict__ V,int ptv,bf16*O,int pto,int NT,const TM tm,char*shm,int wave0){
  int tid_=wave0*64+lane_asm(); asm volatile("":"+v"(tid_)); const int tid=tid_,lane=tid&63,r32=lane&31,hi=lane>>5; const int wid=__builtin_amdgcn_readfirstlane(tid>>6);
  const bf16*Qw=Q+(long)(wid*QBLK)*ptq;
  const bf16*Kh=K,*Vh=V;
  const unsigned lds0=(unsigned)(uintptr_t)shm;
  float*wsf=(float*)(shm+LDS_WS)+wid*64;
  const bf16*ksrc=Kh+(long)lane*ptk+wid*8;
  const bf16*vsrc=Vh+(long)(16*(wid&3)+(lane>>2))*ptv+(wid>>2)*32+(lane&3)*8;
  const unsigned kdst=lds0+LDS_K+wid*1024, vdst=lds0+LDS_V+wid*1024;
  #define DMA_K(t,slot) glds16(ksrc+(long)tm.row(t)*ptk,(unsigned)__builtin_amdgcn_readfirstlane(kdst+(slot)))
  #define DMA_V(t,slot) glds16(vsrc+(long)tm.row(t)*ptv,(unsigned)__builtin_amdgcn_readfirstlane(vdst+(slot)))
  const int vb0=(int)(lds0+LDS_V)+((lane>>4)&1)*32+(lane&3)*8+(4*hi+((lane&15)>>2))*64;
  const char*Kbase=shm+LDS_K; bf16x8 kf[8];
  const lds_cptr shm3=(lds_cptr)shm; const lds_cptr kp0=shm3+LDS_K+hi*1024+r32*16; const lds_cptr vp0=shm3+LDS_V+((lane>>4)&1)*32+(lane&3)*8+(4*hi+((lane&15)>>2))*64;
  DMA_K(0,0);DMA_V(0,0);DMA_K(1,SLOTB);
  bf16x8 qr[4];
  #pragma unroll
  for(int d0=0;d0<4;++d0)qr[d0]=*reinterpret_cast<const bf16x8*>(&Qw[(long)r32*ptq+d0*16+hi*8]);
  float mhat=0.f,l_reg=0.f;f32x16 o[2];o[0]=f32x16{};o[1]=f32x16{};f32x16 negm=f32x16{};asm volatile("":"+v"(negm));
  const int qrel=wid*QBLK+r32;
  #define CMASK(P0,P1,t) do{ if(TM::HAS_MASK) tm.mask(P0,P1,(t),qrel,hi); }while(0)
  bool resc=false;
  #define START(P0,P1) do{ const float rm=rowmax(P0,P1); resc=false; \
    { const float dl=rm; mhat=fadd_s(mhat,dl); \
      _Pragma("unroll") for(int r=0;r<16;++r){P0[r]=fsub_s(P0[r],dl);P1[r]=fsub_s(P1[r],dl);} \
      _Pragma("unroll") for(int r=0;r<16;++r)negm[r]=-mhat; asm volatile("":"+v"(negm)); } \
    _Pragma("unroll") for(int r=0;r<16;++r)P0[r]=__builtin_amdgcn_exp2f(P0[r]); }while(0)
  #define RESC() do{ if(resc){ asm volatile("s_waitcnt lgkmcnt(0)":::"memory"); \
      _Pragma("unroll") for(int d_=0;d_<2;++d_) _Pragma("unroll") for(int r=0;r<16;++r)o[d_][r]*=wsf[crow(r,hi)]; } }while(0)
  f32x16 pA0,pA1,pB0,pB1;
  int sl_prev=0,sl_cur=0,sl_next=SLOTB;
  #define ROT() do{sl_prev=sl_cur;sl_cur=sl_next;sl_next=(sl_next==(NSLOT-1)*SLOTB)?0:sl_next+SLOTB;}while(0)
  DMA_K(2,2*SLOTB);
  WAIT_BAR(3);
  qkt(pA0,pA1,Kbase,qr,negm,r32,hi);asm volatile("s_nop 15\n\ts_nop 7":"+v"(pA0),"+v"(pA1));
  START(pA0,pA1);
  _Pragma("unroll") for(int r=0;r<16;++r)pA1[r]=__builtin_amdgcn_exp2f(pA1[r]);
  WAIT_BAR(0);
  DMA_K(3,0);DMA_V(1,SLOTB);
  ROT();
  kload8(kf,kp0+sl_cur);
  WAIT_BAR(2);
  s16x4 vlo[8],vhi[8]; u32x4 pw0,pw1,pw2,pw3;
  #define PKW(P,B) cvtpk_s(P[B],P[B+1])
  #define PAF(k) __builtin_bit_cast(bf16x8,pw##k)
  #define VFR(i) (bf16x8){vlo[i][0],vlo[i][1],vlo[i][2],vlo[i][3],vhi[i][0],vhi[i][1],vhi[i][2],vhi[i][3]}
  #define PIN(x) asm volatile("":"+v"(x))
  #define MX3(a,b,c) __builtin_fmaxf(__builtin_fmaxf((a),(b)),(c))
  #define GAPA(MF,A0,A1,A2,A3,W0,W1,PW) do{ MF; sacc+=A0; sacc+=A1; sacc+=A2; sacc+=A3; PIN(sacc); W0; W1; PIN(PW); SBAR(); }while(0)
  #define EX(v) __builtin_amdgcn_exp2f(v)
  #define GAPB(MF,X,B) do{ MF; X[B]=EX(X[B]); X[B+1]=EX(X[B+1]); X[B+2]=EX(X[B+2]); X[B+3]=EX(X[B+3]); PIN(X); SBAR(); }while(0)
  #define VRD(i) do{ vlo[i]=vtr(vp_+(((i)>>2)*4096+((i)&3)*1024)); vhi[i]=vtr(vp_+(((i)>>2)*4096+((i)&3)*1024+512)); }while(0)
  #define KRD(G,j) do{ if(G){ kload2(kf,kp0+sl_next,j); SBAR(); } }while(0)
  #define STEP(C0,C1,P0,P1,t,GK,GV,GL) do{ SBAR(); \
    const lds_cptr vp_=vp0+sl_prev; \
    VRD(0); SBAR(); float sacc=(P0[0]+P0[1]); \
    GAPA(C0=__builtin_amdgcn_mfma_f32_32x32x16_bf16(kf[0],qr[0],negm,0,0,0), P0[2],P0[3],P0[4],P0[5],     pw0[0]=PKW(P0,0), pw0[1]=PKW(P0,2), pw0); \
    VRD(4); SBAR(); GAPA(C1=__builtin_amdgcn_mfma_f32_32x32x16_bf16(kf[1],qr[0],negm,0,0,0), P0[6],P0[7],P0[8],P0[9],     pw0[2]=PKW(P0,4), pw0[3]=PKW(P0,6), pw0); \
    VRD(1); SBAR(); GAPA(C0=__builtin_amdgcn_mfma_f32_32x32x16_bf16(kf[2],qr[1],C0,0,0,0),   P0[10],P0[11],P0[12],P0[13], pw1[0]=PKW(P0,8), pw1[1]=PKW(P0,10), pw1); \
    VRD(5); SBAR(); GAPA(C1=__builtin_amdgcn_mfma_f32_32x32x16_bf16(kf[3],qr[1],C1,0,0,0),   P0[14],P0[15],P1[0],P1[1],   pw1[2]=PKW(P0,12),pw1[3]=PKW(P0,14), pw1); \
    VRD(2); SBAR(); GAPA(C0=__builtin_amdgcn_mfma_f32_32x32x16_bf16(kf[4],qr[2],C0,0,0,0),   P1[2],P1[3],P1[4],P1[5],     pw2[0]=PKW(P1,0), pw2[1]=PKW(P1,2), pw2); \
    VRD(6); SBAR(); GAPA(C1=__builtin_amdgcn_mfma_f32_32x32x16_bf16(kf[5],qr[2],C1,0,0,0),   P1[6],P1[7],P1[8],P1[9],     pw2[2]=PKW(P1,4), pw2[3]=PKW(P1,6), pw2); \
    VRD(3); SBAR(); GAPA(C0=__builtin_amdgcn_mfma_f32_32x32x16_bf16(kf[6],qr[3],C0,0,0,0),   P1[10],P1[11],P1[12],P1[13], pw3[0]=PKW(P1,8), pw3[1]=PKW(P1,10), pw3); \
    VRD(7); SBAR(); GAPA(C1=__builtin_amdgcn_mfma_f32_32x32x16_bf16(kf[7],qr[3],C1,0,0,0),   P1[14],P1[15],0.f,0.f,       pw3[2]=PKW(P1,12),pw3[3]=PKW(P1,14), pw3); \
    l_reg+=sacc; \
    if(GK){DMA_K((t)+3,sl_cur);} if(GV){DMA_V((t)+1,sl_next);} \
    CMASK(C0,C1,t); \
    { float a=MX3(C0[0],C0[1],C1[0]),b=MX3(C0[2],C0[3],C1[1]); a=MX3(a,C1[2],C1[3]); \
      _Pragma("unroll") for(int r=4;r<16;r+=4){a=MX3(a,C0[r],C0[r+1]);b=MX3(b,C0[r+2],C0[r+3]);a=MX3(a,C1[r],C1[r+1]);b=MX3(b,C1[r+2],C1[r+3]);} \
      float rm=__builtin_fmaxf(a,b); { auto rr=__builtin_amdgcn_permlane32_swap(__float_as_uint(rm),__float_as_uint(rm),false,false); rm=__builtin_fmaxf(__uint_as_float(rr[0]),__uint_as_float(rr[1])); } \
      resc=false; \
      if(__builtin_expect(__any(rm>(float)THRL),0)){ const float dl=__builtin_fmaxf(rm,0.f); mhat+=dl; \
        _Pragma("unroll") for(int r=0;r<16;++r){C0[r]-=dl;C1[r]-=dl;} \
        _Pragma("unroll") for(int r=0;r<16;++r)negm[r]=-mhat; asm volatile("":"+v"(negm)); \
        const float f=__builtin_amdgcn_exp2f(-dl); l_reg*=f; if(hi==0)wsf[r32]=f; resc=true; } } \
    SBAR(); \
    GAPB(o[0]=__builtin_amdgcn_mfma_f32_32x32x16_bf16(PAF(0),VFR(0),o[0],0,0,0), C0,0); \
    GAPB(o[1]=__builtin_amdgcn_mfma_f32_32x32x16_bf16(PAF(0),VFR(4),o[1],0,0,0), C0,4); \
    KRD(GL,0); GAPB(o[0]=__builtin_amdgcn_mfma_f32_32x32x16_bf16(PAF(1),VFR(1),o[0],0,0,0), C0,8); \
    KRD(GL,1); GAPB(o[1]=__builtin_amdgcn_mfma_f32_32x32x16_bf16(PAF(1),VFR(5),o[1],0,0,0), C0,12); \
    KRD(GL,2); GAPB(o[0]=__builtin_amdgcn_mfma_f32_32x32x16_bf16(PAF(2),VFR(2),o[0],0,0,0), C1,0); \
    KRD(GL,3); GAPB(o[1]=__builtin_amdgcn_mfma_f32_32x32x16_bf16(PAF(2),VFR(6),o[1],0,0,0), C1,4); \
    GAPB(o[0]=__builtin_amdgcn_mfma_f32_32x32x16_bf16(PAF(3),VFR(3),o[0],0,0,0), C1,8); \
    GAPB(o[1]=__builtin_amdgcn_mfma_f32_32x32x16_bf16(PAF(3),VFR(7),o[1],0,0,0), C1,12); \
    }while(0)
  int t=1;
  for(;t+5<NT;t+=2){
    STEP(pB0,pB1,pA0,pA1,t,true,true,true);     WAIT_BAR(2); RESC(); ROT();
    STEP(pA0,pA1,pB0,pB1,t+1,true,true,true);   WAIT_BAR(2); RESC(); ROT();
  }
  #define ENDW(tt) do{ if((tt)+3<NT){WAIT_BAR(2);} else if((tt)+2<NT){WAIT_BAR(1);} else {WAIT_BAR(0);} }while(0)
  for(;t+1<NT;t+=2){
    STEP(pB0,pB1,pA0,pA1,t,(t+3<NT),(t+1<NT),(t+1<NT));       ENDW(t);   RESC(); ROT();
    STEP(pA0,pA1,pB0,pB1,t+1,(t+4<NT),(t+2<NT),(t+2<NT));     ENDW(t+1); RESC(); ROT();
  }
  STEP(pB0,pB1,pA0,pA1,NT-1,false,false,false); RESC();
  { float sacc=pB0[0]+pB0[1]; _Pragma("unroll") for(int r=2;r<16;++r)sacc+=pB0[r]; _Pragma("unroll") for(int r=0;r<16;++r)sacc+=pB1[r]; l_reg+=sacc;
    pw0=(u32x4){PKW(pB0,0),PKW(pB0,2),PKW(pB0,4),PKW(pB0,6)};pw1=(u32x4){PKW(pB0,8),PKW(pB0,10),PKW(pB0,12),PKW(pB0,14)};pw2=(u32x4){PKW(pB1,0),PKW(pB1,2),PKW(pB1,4),PKW(pB1,6)};pw3=(u32x4){PKW(pB1,8),PKW(pB1,10),PKW(pB1,12),PKW(pB1,14)};
    SBAR(); pv(o,vb0+sl_cur,PAF(0),PAF(1),PAF(2),PAF(3)); }
  #undef PKW
  #undef PAF
  #undef VFR
  #undef PIN
  #undef MX3
  #undef GAPA
  #undef GAPB
  #undef EX
  #undef VRD
  #undef KRD
  #undef STEP
  #undef ENDW
  {auto rr=__builtin_amdgcn_permlane32_swap(__float_as_uint(l_reg),__float_as_uint(l_reg),false,false);l_reg=__uint_as_float(rr[0])+__uint_as_float(rr[1]);}
  if(hi==0)wsf[32+r32]=l_reg;asm volatile("s_waitcnt lgkmcnt(0)":::"memory");
  float rli[16];
  #pragma unroll
  for(int r=0;r<16;++r)rli[r]=__builtin_amdgcn_rcpf(wsf[32+crow(r,hi)]);
  bf16*Ow=O+(long)(wid*QBLK)*pto;
  { bf16*stg=(bf16*)(shm+LDS_OST)+wid*2048;
    #pragma unroll
    for(int r=0;r<16;++r){const int orow=crow(r,hi);
      #pragma unroll
      for(int d0=0;d0<2;++d0)stg[orow*64+d0*32+r32]=__float2bfloat16(o[d0][r]*rli[r]);}
    asm volatile("s_waitcnt lgkmcnt(0)":::"memory");
    #pragma unroll
    for(int i=0;i<4;++i){const int row=i*8+(lane>>3),ch=lane&7; const u32x4 v=*(const u32x4*)(stg+row*64+ch*8); ATTN_STORE16(Ow+(long)row*pto+ch*8,v);} }
  asm volatile("s_waitcnt lgkmcnt(0)\n\ts_barrier":::"memory");
  #undef DMA_K
  #undef DMA_V
  #undef CMASK
  #undef START
  #undef RESC
  #undef ROT
}
constexpr int ATTN_LDS_BYTES=LDS_BYTES;
#undef SBAR
#undef WAIT_BAR
}
#define GAS __attribute__((address_space(1)))
#define LAS __attribute__((address_space(3)))
typedef unsigned short bf16;
typedef unsigned v4u __attribute__((ext_vector_type(4)));
typedef unsigned v2u __attribute__((ext_vector_type(2)));
typedef float f32x4 __attribute__((ext_vector_type(4)));
typedef float f32x16 __attribute__((ext_vector_type(16)));
typedef short bf16x8 __attribute__((ext_vector_type(8)));

constexpr int DMODEL = 1024, NBATCH = 4, SEQ = 8192, CTXL = 256, TPB = SEQ + CTXL, MROWS = NBATCH * TPB;
constexpr int FFH = 2816, NUP = 2 * FFH, NIN_E = 3072, NIN_O = 2304;
constexpr float EPS = 1e-6f;
constexpr float QSCALE = 0.125f * 1.4426950408889634f;
constexpr int NWAVES = 8, NTHREADS = 512;
constexpr int RING_BYTES = 131072, MISC_OFF = 139264, LDS_BYTES = 147456;

constexpr size_t MiB = (size_t)1 << 20;
constexpr size_t WS_CTL = 0, CTL_ZERO_BYTES = 64 * 1024;
constexpr size_t WS_MODS = 1 * MiB, WS_ROPE = 2 * MiB, WS_H3L = 4 * MiB, WS_H3C = 8 * MiB, WS_PART = 9 * MiB;
constexpr size_t WS_W = 10 * MiB, WS_WIN = WS_W, WS_WOUT = WS_W + 6 * MiB, WS_WUP = WS_W + 8 * MiB, WS_WDOWN = WS_W + 19 * MiB;
constexpr size_t WS_XC = 36 * MiB, WS_FILT = 40 * MiB, WS_FILTC = 72 * MiB, WS_YTC = 73 * MiB;
constexpr size_t WS_H = 74 * MiB, WS_U = 140 * MiB, WS_ZT = 338 * MiB, WS_X0T = 370 * MiB, WS_DAO = 338 * MiB, WS_GV = 140 * MiB;
constexpr size_t WS_END = 512 * MiB;
static_assert(WS_GV + (size_t)MROWS * NUP * 2 <= WS_END && WS_U + (size_t)MROWS * NIN_E * 2 <= WS_ZT && WS_DAO + (size_t)MROWS * 1024 * 2 <= WS_END, "ws map");
constexpr int CW_QUEUE = 1024;
constexpr int CW_BAR = 8192;

struct Args { const float* in[37]; float* out; unsigned char* ws; };
enum { I_X = 0, I_C, I_CTX, I_CCTX, I_WADA, I_BADA, I_WUP, I_FCW, I_FCB, I_WDOWN, I_WINE, I_WOUTE, I_NAQG, I_NAKG, I_RPB, I_DAQG, I_DAKG, I_LQ1, I_LK1, I_LQ2, I_LK2, I_SUBLN,
       I_WINO, I_WOUTO, I_GQG, I_GKG, I_HCW, I_HCB, I_HW1, I_HB1, I_HW2, I_HB2, I_HW3, I_HB3, I_HW4, I_HFREQ, I_HSKIP };

struct Frame { LAS unsigned char* lds; int tid, lane, wave, G, bid, wave0; };

__device__ __forceinline__ unsigned f2bf(float f) { unsigned u = __builtin_bit_cast(unsigned, f); return (u + 0x7fffu + ((u >> 16) & 1u)) >> 16; }
__device__ __forceinline__ unsigned pk2(float lo, float hi) { return f2bf(lo) | (f2bf(hi) << 16); }
__device__ __forceinline__ float bf2f(unsigned short h) { return __builtin_bit_cast(float, (unsigned)h << 16); }
__device__ __forceinline__ float bflo(unsigned w) { return __builtin_bit_cast(float, w << 16); }
__device__ __forceinline__ float bfhi(unsigned w) { return __builtin_bit_cast(float, w & 0xffff0000u); }
__device__ __forceinline__ float wave_sum(float v, int lane) {
#pragma unroll
    for (int o = 1; o < 64; o <<= 1) v += shfl_l(v, lane ^ o);
    return v;
}
#define LDS_WAIT() asm volatile("s_waitcnt lgkmcnt(0)" ::: "memory")

__device__ __forceinline__ const float* xrow_c(const float* xl, const float* xc, int row) { const int b = row / TPB, t = row - b * TPB; return t < SEQ ? xl + ((size_t)b * SEQ + t) * DMODEL : xc + ((size_t)b * CTXL + (t - SEQ)) * DMODEL; }
__device__ __forceinline__ float* xrow_m(float* xl, float* xc, int row) { const int b = row / TPB, t = row - b * TPB; return t < SEQ ? xl + ((size_t)b * SEQ + t) * DMODEL : xc + ((size_t)b * CTXL + (t - SEQ)) * DMODEL; }
__device__ __forceinline__ int modrow(int row) { const int b = row / TPB, t = row - b * TPB; return t < SEQ ? b : 4; }

struct EpiStore {
    static constexpr bool PERM = true, AFTER_DRAIN = false;
    bf16* O; int ldc;
    __device__ __forceinline__ void operator()(const pg8::f32x4 (&acc)[2][2][4][2], const pg8::Unit& u, int wr, int wc, int fr, int fq) const {
        const int row0 = u.pm * 256 + wr * 64 + fr, col0 = u.pn * 256 + wc * 32 + 8 * fq;
#pragma unroll
        for (int ai = 0; ai < 2; ++ai)
#pragma unroll
            for (int m = 0; m < 4; ++m) { bf16* rowp = O + (size_t)(row0 + ai * 128 + m * 16) * ldc + col0;
#pragma unroll
                for (int bj = 0; bj < 2; ++bj) { const pg8::f32x4 v0 = acc[ai][bj][m][0], v1 = acc[ai][bj][m][1];
                    v4u w; w.x = pg8::cvt_pk_bf16(v0[0], v0[1]); w.y = pg8::cvt_pk_bf16(v0[2], v0[3]); w.z = pg8::cvt_pk_bf16(v1[0], v1[1]); w.w = pg8::cvt_pk_bf16(v1[2], v1[3]);
                    *(v4u*)(rowp + bj * 128) = w; } }
    }
};
struct EpiResid {
    static constexpr bool PERM = false, AFTER_DRAIN = false;
    const float* sl; const float* sc; float* dl; float* dc; const float* gate; float mul = 1.f;
    __device__ __forceinline__ void operator()(const pg8::f32x4 (&acc)[2][2][4][2], const pg8::Unit& u, int wr, int wc, int fr, int fq) const {
        const int col0 = u.pn * 256 + wc * 32 + 4 * fq;
        const int r0 = u.pm * 256, b = r0 / TPB, t0 = r0 - b * TPB; const bool lat = t0 < SEQ;
        const float* sp0 = (lat ? sl + ((size_t)b * SEQ + t0) * DMODEL : sc + ((size_t)b * CTXL + (t0 - SEQ)) * DMODEL) + col0;
        float* dp0 = (lat ? dl + ((size_t)b * SEQ + t0) * DMODEL : dc + ((size_t)b * CTXL + (t0 - SEQ)) * DMODEL) + col0;
        const float* gp = gate + (size_t)(lat ? b : 4) * 6144 + col0;
        f32x4 gv[2][2];
#pragma unroll
        for (int bj = 0; bj < 2; ++bj)
#pragma unroll
            for (int n = 0; n < 2; ++n) gv[bj][n] = *(const f32x4*)(gp + bj * 128 + n * 16) * mul;
#pragma unroll
        for (int am = 0; am < 4; ++am) {
            const int ai = am >> 1, m0 = (am & 1) * 2;
            f32x4 xv[2][2][2];
#pragma unroll
            for (int mm = 0; mm < 2; ++mm) { const float* sp = sp0 + (size_t)(ai * 128 + wr * 64 + (m0 + mm) * 16 + fr) * DMODEL;
#pragma unroll
                for (int bj = 0; bj < 2; ++bj)
#pragma unroll
                    for (int n = 0; n < 2; ++n) xv[mm][bj][n] = *(const f32x4*)(sp + bj * 128 + n * 16); }
            asm volatile("" ::: "memory");
#pragma unroll
            for (int mm = 0; mm < 2; ++mm) { float* dp = dp0 + (size_t)(ai * 128 + wr * 64 + (m0 + mm) * 16 + fr) * DMODEL;
#pragma unroll
                for (int bj = 0; bj < 2; ++bj)
#pragma unroll
                    for (int n = 0; n < 2; ++n) { const f32x4 x = xv[mm][bj][n], g = gv[bj][n];
                        const pg8::f32x4 a = acc[ai][bj][m0 + mm][n]; f32x4 o; o.x = x.x + g.x * a[0]; o.y = x.y + g.y * a[1]; o.z = x.z + g.z * a[2]; o.w = x.w + g.w * a[3];
                        *(f32x4*)(dp + bj * 128 + n * 16) = o; } }
            asm volatile("" ::: "memory");
        }
    }
};

struct EpiConv {
    static constexpr bool PERM = true, AFTER_DRAIN = false;
    bf16* ACT; const float* cw; const float* cb;
    __device__ __forceinline__ void operator()(const pg8::f32x4 (&acc)[2][2][4][2], const pg8::Unit& u, int wr, int wc, int fr, int fq) const {
        const int j0 = u.pn * 128 + wc * 32 + 8 * fq;
        float w0[8], w1[8], w2[8], bb[8];
#pragma unroll
        for (int e = 0; e < 8; ++e) { w0[e] = cw[j0 + e]; w1[e] = cw[FFH + j0 + e]; w2[e] = cw[2 * FFH + j0 + e]; bb[e] = cb[j0 + e]; }
#pragma unroll
        for (int ai = 0; ai < 2; ++ai) {
            const int blk0 = u.pm * 248 + 62 * (2 * ai + wr) - 1;
#pragma unroll
            for (int m = 0; m < 4; ++m) {
                const int rho = 16 * m + fr, gr = blk0 + rho; const int ts = gr % TPB;
                const bool zp = (ts == 0) || (ts == SEQ), zn = (ts == SEQ - 1) || (ts == TPB - 1);
                unsigned ow[4];
#pragma unroll
                for (int n = 0; n < 2; ++n)
#pragma unroll
                    for (int e = 0; e < 4; e += 2) { float r2[2];
#pragma unroll
                        for (int q = 0; q < 2; ++q) { const int ee = e + q, ce = 4 * n + ee;
                            const float g = acc[ai][0][m][n][ee], v = acc[ai][1][m][n][ee];
                            const float gm1 = acc[ai][0][m > 0 ? m - 1 : 0][n][ee], gp1 = acc[ai][0][m < 3 ? m + 1 : 3][n][ee];
                            const float pa = __builtin_bit_cast(float, __builtin_amdgcn_update_dpp(0, __builtin_bit_cast(int, fr == 15 ? gm1 : g), 0x121, 0xf, 0xf, false));
                            const float na = __builtin_bit_cast(float, __builtin_amdgcn_update_dpp(0, __builtin_bit_cast(int, fr == 0 ? gp1 : g), 0x12F, 0xf, 0xf, false));
                            const float prev = zp ? 0.f : pa, next = zn ? 0.f : na;
                            const float t = w0[ce] * prev + w1[ce] * g + w2[ce] * next + bb[ce];
                            r2[q] = t * __builtin_amdgcn_rcpf(1.f + __expf(-t)) * v; }
                        ow[2 * n + (e >> 1)] = pg8::cvt_pk_bf16(r2[0], r2[1]); }
                if (rho >= 1 && rho <= 62 && gr < MROWS) *(v4u*)(ACT + (size_t)gr * FFH + j0) = (v4u){ow[0], ow[1], ow[2], ow[3]};
            }
        }
    }
};

__device__ __forceinline__ void ctx_strip_gemm(const Frame& F0, const bf16* A, int lda, const bf16* Wt, int K, const float* xc_src, float* xc_dst, const float* gate_ctx, int ncb = 16, bf16* outb = nullptr, int ldo = 0) {
    int tid = F0.wave0 * 64 + lane_asm(); asm volatile("" : "+v"(tid));
    const int lane = tid & 63, wave = __builtin_amdgcn_readfirstlane(tid >> 6), fr = lane & 15, fq = lane >> 4;
    LAS f32x4* red = (LAS f32x4*)F0.lds;
    const int kc = K >> 3;
    for (int it = F0.bid; it < 16 * ncb; it += F0.G) {
        const int rs = it / ncb, cb = it - rs * ncb;
        const bf16* ap[4]; const bf16* bp[4];
#pragma unroll
        for (int g = 0; g < 4; ++g) { const int cr = rs * 64 + g * 16 + fr, b = cr >> 8, t = cr & 255;
            ap[g] = A + ((size_t)b * TPB + SEQ + t) * lda + wave * kc + 8 * fq; bp[g] = Wt + (size_t)(cb * 64 + g * 16 + fr) * K + wave * kc + 8 * fq; }
        f32x4 acc[4][4];
#pragma unroll
        for (int rg = 0; rg < 4; ++rg)
#pragma unroll
            for (int cg = 0; cg < 4; ++cg) acc[rg][cg] = (f32x4){0.f, 0.f, 0.f, 0.f};
#pragma unroll 2
        for (int k0 = 0; k0 < kc; k0 += 32) {
            bf16x8 av[4], bv[4];
#pragma unroll
            for (int g = 0; g < 4; ++g) { av[g] = *(const bf16x8*)(ap[g] + k0); bv[g] = *(const bf16x8*)(bp[g] + k0); }
#pragma unroll
            for (int rg = 0; rg < 4; ++rg)
#pragma unroll
                for (int cg = 0; cg < 4; ++cg) acc[rg][cg] = __builtin_amdgcn_mfma_f32_16x16x32_bf16(bv[cg], av[rg], acc[rg][cg], 0, 0, 0);
        }
#pragma unroll
        for (int rg = 0; rg < 4; ++rg)
#pragma unroll
            for (int cg = 0; cg < 4; ++cg) red[(wave * 16 + rg * 4 + cg) * 64 + lane] = acc[rg][cg];
        __syncthreads();
#pragma unroll
        for (int h = 0; h < 2; ++h) { const int o = tid + 512 * h, tile = o >> 6, ln = o & 63, rg = tile >> 2, cg = tile & 3, ofr = ln & 15, ofq = ln >> 4;
            f32x4 s = red[o];
#pragma unroll
            for (int w = 1; w < 8; ++w) s += red[w * 1024 + o];
            const int cr = rs * 64 + rg * 16 + ofr, b = cr >> 8, t = cr & 255, col = cb * 64 + cg * 16 + 4 * ofq;
            if (outb) { v2u o; o.x = pk2(s.x, s.y); o.y = pk2(s.z, s.w); *(v2u*)(outb + ((size_t)b * TPB + SEQ + t) * ldo + col) = o; }
            else { const size_t xo = ((size_t)b * CTXL + t) * DMODEL + col;
                const f32x4 x0 = *(const f32x4*)(xc_src + xo), g0 = *(const f32x4*)(gate_ctx + col);
                *(f32x4*)(xc_dst + xo) = x0 + g0 * s; } }
        __syncthreads();
    }
}

__device__ __forceinline__ void transpose_item(const float* W, int K, int N, bf16* WT, LAS float* scr, int item, int lane, bool upmap = false) {
    const int nblk = N / 32, kb = item / nblk, nb = item % nblk, k0 = 64 * kb, n0 = 32 * nb;
    float wv[32];
#pragma unroll
    for (int i = 0; i < 32; ++i) wv[i] = W[(size_t)(k0 + 2 * i + (lane >> 5)) * N + n0 + (lane & 31)];
#pragma unroll
    for (int i = 0; i < 32; ++i) { const int kk = 2 * i + (lane >> 5); scr[kk * 33 + (lane & 31)] = wv[i]; }
    LDS_WAIT();
    const int c = lane & 7;
#pragma unroll
    for (int j = 0; j < 4; ++j) { const int n = (lane >> 3) + 8 * j; const LAS float* s = scr + (8 * c) * 33 + n;
        v4u o; o.x = pk2(s[0 * 33], s[1 * 33]); o.y = pk2(s[2 * 33], s[3 * 33]); o.z = pk2(s[4 * 33], s[5 * 33]); o.w = pk2(s[6 * 33], s[7 * 33]);
        const int nn = n0 + n, drow = !upmap ? nn : (nn < FFH ? 256 * (nn >> 7) + (nn & 127) : 256 * ((nn - FFH) >> 7) + 128 + ((nn - FFH) & 127));
        *(v4u*)(WT + (size_t)drow * K + k0 + 8 * c) = o; }
    LDS_WAIT();
}
typedef unsigned v4u_unused_;
#define RLX_AGENT __ATOMIC_RELAXED, __HIP_MEMORY_SCOPE_AGENT
#define XB_TMO      128
#define XB_XCNT(j)  (256  + 64 * (j))
#define XB_XSUB(j)  (1280 + 64 * (j))
#define XB_XGEN(j)  (2304 + 64 * (j))
#define XB_TOP      3328
#define XB_TOPGEN   3392
#define XCD_BAR_WORDS 3456
#define XB_SPIN_CAP (1u << 18)

__device__ __forceinline__ unsigned xb_ld(unsigned* p)              { return __hip_atomic_load(p, __ATOMIC_RELAXED, __HIP_MEMORY_SCOPE_AGENT); }
__device__ __forceinline__ unsigned xb_add(unsigned* p, unsigned v) { return __hip_atomic_fetch_add(p, v, __ATOMIC_RELAXED, __HIP_MEMORY_SCOPE_AGENT); }
__device__ __forceinline__ unsigned xb_xcc_id() { return (unsigned)__builtin_amdgcn_s_getreg((3 << 11) | 20) & 0xFu; }
#define XB_SPIN(cond, bar) do { unsigned _sp = 0; while (cond) { __builtin_amdgcn_s_sleep(1); \
    if ((++_sp & 255u) == 0u) { if (xb_ld(&(bar)[XB_TMO])) break; if (_sp > XB_SPIN_CAP) { atomicAdd(&(bar)[XB_TMO], 1u); break; } } } } while (0)

struct XcdBarrier {
    unsigned* bar; unsigned x;
    volatile LAS unsigned* st;
};

__device__ __forceinline__ XcdBarrier xcd_barrier_post(unsigned* bar, volatile LAS unsigned* st) {
    XcdBarrier b; b.bar = bar; b.x = xb_xcc_id(); b.st = st;
    if (threadIdx.x == 0) (void)xb_add(&bar[XB_XCNT(b.x)], 1u);
    return b;
}
__device__ __forceinline__ void xcd_barrier_complete(unsigned* bar, unsigned x, unsigned& nloc, unsigned& nx) {
    asm volatile("" : "+s"(bar));
    asm volatile("" : "+s"(x));
    const unsigned G = gridDim.x * gridDim.y * gridDim.z;
    unsigned sum, cnt, mine, sp = 0u;
    for (;;) {
        sum = 0u; cnt = 0u; mine = 0u;
#pragma unroll
        for (unsigned j = 0; j < 16; ++j) { const unsigned c = xb_ld(&bar[XB_XCNT(j)]); sum += c; cnt += (c > 0u) ? 1u : 0u; mine = (j == x) ? c : mine; }
        if (sum == G) break;
        __builtin_amdgcn_s_sleep(1);
        if ((++sp & 255u) == 0u) { if (xb_ld(&bar[XB_TMO])) break; if (sp > XB_SPIN_CAP) { atomicAdd(&bar[XB_TMO], 1u); break; } }
    }
    nloc = mine > 0u ? mine : 1u; nx = cnt > 0u ? cnt : 1u;
}

__device__ __forceinline__ void xcd_barrier(const XcdBarrier& b) {
    asm volatile("s_waitcnt vmcnt(0)" ::: "memory");
    __syncthreads();
    if (threadIdx.x == 0) {
        unsigned* bar = b.bar; asm volatile("" : "+s"(bar));
        __builtin_amdgcn_s_waitcnt(0);
        unsigned nloc = b.st[0], nx = b.st[1];
        if (nloc == 0u) { xcd_barrier_complete(bar, b.x, nloc, nx); b.st[0] = nloc; b.st[1] = nx; }
        const unsigned old = xb_add(&bar[XB_XSUB(b.x)], 1u);
        const unsigned gen = old / nloc;
        if (old + 1u == (gen + 1u) * nloc) {
            __builtin_amdgcn_fence(__ATOMIC_RELEASE, "agent");
            asm volatile("s_waitcnt vmcnt(0)" ::: "memory");
            const unsigned og = xb_add(&bar[XB_TOP], 1u);
            const unsigned tg = og / nx;
            if (og + 1u == (tg + 1u) * nx) xb_add(&bar[XB_TOPGEN], 1u);
            else XB_SPIN(xb_ld(&bar[XB_TOPGEN]) == tg, bar);
            __builtin_amdgcn_fence(__ATOMIC_ACQUIRE, "agent");
            xb_add(&bar[XB_XGEN(b.x)], 1u);
            asm volatile("s_waitcnt vmcnt(0)" ::: "memory");
        } else {
            XB_SPIN(xb_ld(&bar[XB_XGEN(b.x)]) == gen, bar);
            __builtin_amdgcn_fence(__ATOMIC_ACQUIRE, "agent");
            asm volatile("s_waitcnt vmcnt(0)" ::: "memory");
        }
    }
    __syncthreads();
}
__device__ __forceinline__ void p0_prologue(Frame& F0, const Args& a) {
    Frame F = F0; { int t_ = F0.wave0 * 64 + lane_asm(); asm volatile("" : "+v"(t_)); F.tid = t_; F.lane = t_ & 63; F.wave = __builtin_amdgcn_readfirstlane(t_ >> 6); } int lz = 0; asm volatile("" : "+s"(lz)); unsigned char* wsl = (unsigned char*)((unsigned long long)a.ws ^ (unsigned long long)(unsigned)lz);
    unsigned char* ws = wsl;
    float* MODS = (float*)(ws + WS_MODS);
    LAS float* sC = (LAS float*)F.lds;
    LAS float* red = sC + 5 * 1024;
    for (int i = F.tid; i < 5 * 1024; i += NTHREADS) { const float v = i < 4096 ? a.in[lz + I_C][i] : a.in[lz + I_CCTX][i - 4096]; sC[i] = v / (1.f + expf(-v)); }
    __syncthreads();
    for (int it = F.bid; it < 384; it += F.G) {
        const int l = it / 96, n0 = (it % 96) * 64, n = n0 + F.lane;
        const float* W = a.in[lz + I_WADA] + (size_t)l * 1024 * 6144 + n;
        float a0 = 0.f, a1 = 0.f, a2 = 0.f, a3 = 0.f, a4 = 0.f;
        const int k0 = F.wave * 128;
#pragma unroll 16
        for (int k = k0; k < k0 + 128; ++k) { const float w = W[(size_t)k * 6144];
            a0 += sC[k] * w; a1 += sC[1024 + k] * w; a2 += sC[2048 + k] * w; a3 += sC[3072 + k] * w; a4 += sC[4096 + k] * w; }
        red[(F.wave * 5 + 0) * 64 + F.lane] = a0; red[(F.wave * 5 + 1) * 64 + F.lane] = a1; red[(F.wave * 5 + 2) * 64 + F.lane] = a2;
        red[(F.wave * 5 + 3) * 64 + F.lane] = a3; red[(F.wave * 5 + 4) * 64 + F.lane] = a4;
        __syncthreads();
        if (F.tid < 320) { const int r = F.tid >> 6, ln = F.tid & 63; float s = 0.f;
#pragma unroll
            for (int w = 0; w < 8; ++w) s += red[(w * 5 + r) * 64 + ln];
            MODS[((size_t)l * 5 + r) * 6144 + n0 + ln] = s + a.in[lz + I_BADA][l * 6144 + n0 + ln]; }
        __syncthreads();
    }
    float* ROPE = (float*)(ws + WS_ROPE);
    for (int idx = F.bid * NTHREADS + F.tid; idx < SEQ * 32; idx += F.G * NTHREADS) {
        const int t = idx >> 5, pi = idx & 31, pos = pi < 16 ? (t >> 6) : (t & 63), m = pi & 15;
        const float inv = powf(10000.f, -(float)m / 16.f), ang = (float)pos * inv;
        ROPE[2 * idx] = cosf(ang); ROPE[2 * idx + 1] = sinf(ang);
    }
    float* H3L = (float*)(ws + WS_H3L); float* H3C = (float*)(ws + WS_H3C);
    for (int item = F.bid * NWAVES + F.wave; item < 2 * 8448; item += F.G * NWAVES) {
        const int i = item / 8448, rem = item % 8448, type = rem >= 8192 ? 1 : 0, p = type ? rem - 8192 : rem, L = type ? 256 : 8192;
        const int e = F.lane;
        const float tt = (float)p / (float)(L - 1);
        const float w = 6.283185307179586f * (float)p / (float)L;
        float zv = 0.f;
        if (e == 0) zv = tt;
        else if (e <= 32) { const int m = (e - 1) & 15; const float f = 1e-4f + (float)m * ((15.f - 1e-4f) / 15.f); const float ar = f * w; zv = e <= 16 ? cosf(ar) : -sinf(ar); }
        const float fr = a.in[lz + I_HFREQ][i * 64 + e];
        float acc = a.in[lz + I_HB1][i * 64 + e];
        for (int k = 0; k < 33; ++k) acc += shfl_l(zv, k) * a.in[lz + I_HW1][(i * 33 + k) * 64 + e];
        float h = sinf(fr * acc);
        acc = a.in[lz + I_HB2][i * 64 + e];
        for (int k = 0; k < 64; ++k) acc += shfl_l(h, k) * a.in[lz + I_HW2][(i * 64 + k) * 64 + e];
        h = sinf(fr * acc);
        acc = a.in[lz + I_HB3][i * 64 + e];
        for (int k = 0; k < 64; ++k) acc += shfl_l(h, k) * a.in[lz + I_HW3][(i * 64 + k) * 64 + e];
        h = sinf(fr * acc);
        if (type) H3C[((size_t)i * 256 + p) * 64 + e] = h; else H3L[((size_t)i * 8192 + p) * 64 + e] = h;
    }
}

__device__ __forceinline__ void norm_phase(Frame& F0, const float* xl, const float* xc, const float* mods_l, int shoff, bf16* H) {
    Frame F = F0; { int t_ = F0.wave0 * 64 + lane_asm(); asm volatile("" : "+v"(t_)); F.tid = t_; F.lane = t_ & 63; F.wave = __builtin_amdgcn_readfirstlane(t_ >> 6); } int lz = 0; asm volatile("" : "+s"(lz));
    const int gw = F.bid * NWAVES + F.wave, NGW = F.G * NWAVES;
    for (int row = gw; row < MROWS; row += 3 * NGW) {
        int rw[3]; bool ok[3]; const f32x4* xr[3]; f32x4 v[3][4];
#pragma unroll
        for (int q = 0; q < 3; ++q) { rw[q] = row + q * NGW; ok[q] = rw[q] < MROWS; if (!ok[q]) rw[q] = row; xr[q] = (const f32x4*)xrow_c(xl, xc, rw[q]) + F.lane;
#pragma unroll
            for (int j = 0; j < 4; ++j) v[q][j] = xr[q][64 * j]; }
#pragma unroll
        for (int q = 0; q < 3; ++q) {
            const float* md = mods_l + (size_t)modrow(rw[q]) * 6144 + shoff;
            float s = 0.f;
#pragma unroll
            for (int j = 0; j < 4; ++j) s += (v[q][j].x * v[q][j].x + v[q][j].y * v[q][j].y) + (v[q][j].z * v[q][j].z + v[q][j].w * v[q][j].w);
            const float r = 1.0f / sqrtf(wave_sum(s, F.lane) * (1.f / DMODEL) + EPS);
            unsigned long long* o8 = (unsigned long long*)(H + (size_t)rw[q] * DMODEL) + F.lane;
#pragma unroll
            for (int j = 0; j < 4; ++j) { const f32x4 sh = *((const f32x4*)md + F.lane + 64 * j), sc = *((const f32x4*)(md + 1024) + F.lane + 64 * j);
                const float y0 = v[q][j].x * r * (1.f + sc.x) + sh.x, y1 = v[q][j].y * r * (1.f + sc.y) + sh.y, y2 = v[q][j].z * r * (1.f + sc.z) + sh.z, y3 = v[q][j].w * r * (1.f + sc.w) + sh.w;
                if (ok[q]) o8[64 * j] = (unsigned long long)pk2(y0, y1) | ((unsigned long long)pk2(y2, y3) << 32); }
        }
    }
}

__device__ __forceinline__ void weights_phase(Frame& F0, const Args& a, int l) {
    Frame F = F0; { int t_ = F0.wave0 * 64 + lane_asm(); asm volatile("" : "+v"(t_)); F.tid = t_; F.lane = t_ & 63; F.wave = __builtin_amdgcn_readfirstlane(t_ >> 6); } int lz = 0; asm volatile("" : "+s"(lz)); unsigned char* wsl = (unsigned char*)((unsigned long long)a.ws ^ (unsigned long long)(unsigned)lz);
    unsigned char* ws = wsl; const int even = !(l & 1), i = l >> 1;
    const int nin = even ? NIN_E : NIN_O;
    const float* win = even ? a.in[lz + I_WINE] + (size_t)i * 1024 * NIN_E : a.in[lz + I_WINO] + (size_t)i * 1024 * NIN_O;
    const float* wout = (even ? a.in[lz + I_WOUTE] : a.in[lz + I_WOUTO]) + (size_t)i * 1024 * 1024;
    const float* wup = a.in[lz + I_WUP] + (size_t)l * 1024 * NUP;
    const float* wdown = a.in[lz + I_WDOWN] + (size_t)l * FFH * 1024;
    LAS float* scr = (LAS float*)(F.lds + F.wave * 16384);
    const int n_in = 16 * (nin / 32), n_out = 16 * 32, n_up = 16 * (NUP / 32), n_down = (FFH / 64) * 32;
    const int gw = F.bid * NWAVES + F.wave, NGW = F.G * NWAVES;
    for (int it = gw; it < n_in + n_out + n_up + n_down; it += NGW) {
        int r = it;
        if (r < n_in) { transpose_item(win, 1024, nin, (bf16*)(ws + WS_WIN), scr, r, F.lane); continue; } r -= n_in;
        if (r < n_out) { transpose_item(wout, 1024, 1024, (bf16*)(ws + WS_WOUT), scr, r, F.lane); continue; } r -= n_out;
        if (r < n_up) { transpose_item(wup, 1024, NUP, (bf16*)(ws + WS_WUP), scr, r, F.lane, true); continue; } r -= n_up;
        transpose_item(wdown, FFH, 1024, (bf16*)(ws + WS_WDOWN), scr, r, F.lane);
    }
}

__device__ __forceinline__ void filter_phase(Frame& F0, const Args& a, int l) {
    Frame F = F0; { int t_ = F0.wave0 * 64 + lane_asm(); asm volatile("" : "+v"(t_)); F.tid = t_; F.lane = t_ & 63; F.wave = __builtin_amdgcn_readfirstlane(t_ >> 6); } int lz = 0; asm volatile("" : "+s"(lz)); unsigned char* wsl = (unsigned char*)((unsigned long long)a.ws ^ (unsigned long long)(unsigned)lz);
    unsigned char* ws = wsl; const int i = l >> 1;
    const float* H3L = (const float*)(ws + WS_H3L); const float* H3C = (const float*)(ws + WS_H3C);
    float* FILT = (float*)(ws + WS_FILT); float* FILTC = (float*)(ws + WS_FILTC); float* PART = (float*)(ws + WS_PART);
    const float* w4 = a.in[lz + I_HW4] + (size_t)i * 64 * 1024;
    const float mind = logf(1e-2f) / 1.5f, maxd = logf(1e-2f) / 0.3f;
    LAS float* hs = (LAS float*)(F.lds + F.wave * 16896);
    const int nitem = 2048 + (l == 1 ? 64 : 0);
    const int gw = F.bid * NWAVES + F.wave, NGW = F.G * NWAVES;
    for (int it = gw; it < nitem; it += NGW) {
        const int type = it >= 2048 ? 1 : 0, r = type ? it - 2048 : it, cg = r & 15, chunk = r >> 4, L = type ? 256 : 8192;
        const float* h3 = (type ? H3C + (size_t)i * 256 * 64 : H3L + (size_t)i * 8192 * 64) + (size_t)chunk * 64 * 64;
#pragma unroll 4
        for (int j = 0; j < 16; ++j) { const int e4 = (j * 64 + F.lane) * 4; const f32x4 v = *(const f32x4*)(h3 + e4); LAS float* d = hs + (e4 >> 6) * 65 + (e4 & 63); d[0] = v.x; d[1] = v.y; d[2] = v.z; d[3] = v.w; }
        LDS_WAIT();
        const int p = chunk * 64 + F.lane;
        const float tt = (float)p / (float)(L - 1);
        float acc[32], acb[32];
#pragma unroll
        for (int cc = 0; cc < 32; ++cc) { acc[cc] = 0.f; acb[cc] = 0.f; }
        const float* wrow = w4 + cg * 32 + (F.lane < 32 ? F.lane : 512 + F.lane - 32);
#pragma unroll 2
        for (int k = 0; k < 64; ++k) { const float hv = hs[F.lane * 65 + k]; const float wk = wrow[k * 1024];
#pragma unroll
            for (int cc = 0; cc < 32; ++cc) { acc[cc] += hv * __builtin_bit_cast(float, __builtin_amdgcn_readlane(__builtin_bit_cast(int, wk), cc));
                                              acb[cc] += hv * __builtin_bit_cast(float, __builtin_amdgcn_readlane(__builtin_bit_cast(int, wk), 32 + cc)); } }
        float mys = 0.f;
#pragma unroll
        for (int cc = 0; cc < 32; ++cc) {
            const int c = cg * 32 + cc;
            const float delta = fabsf(mind + (float)c * ((maxd - mind) / 511.f)), decay = expf(-tt * delta);
            const float hf = acc[cc] * decay, hb = acb[cc] * decay;
            if (type) { FILTC[(size_t)c * 512 + p] = hf; FILTC[(size_t)c * 512 + 256 + p] = hb; }
            else { FILT[(size_t)c * 16384 + p] = hf; FILT[(size_t)c * 16384 + 8192 + p] = hb; }
            float s = fabsf(hf) + (p >= 1 ? fabsf(hb) : 0.f); s = wave_sum(s, F.lane);
            mys = (F.lane == cc) ? s : mys;
        }
        if (F.lane < 32) PART[(size_t)(type * 128 + chunk) * 512 + cg * 32 + F.lane] = mys;
        LDS_WAIT();
    }
}

__device__ __forceinline__ v4u qk_compute(v4u w, const float* gain, bool isq, bool rope, const float* rp, int lane) {
    float x[8] = {bflo(w.x), bfhi(w.x), bflo(w.y), bfhi(w.y), bflo(w.z), bfhi(w.z), bflo(w.w), bfhi(w.w)};
    float ss = 0.f;
#pragma unroll
    for (int e = 0; e < 8; ++e) ss += x[e] * x[e];
    ss += shfl_l(ss, lane ^ 1); ss += shfl_l(ss, lane ^ 2); ss += shfl_l(ss, lane ^ 4);
    const float r = 1.0f / sqrtf(ss * (1.f / 64.f) + EPS);
    const f32x4 g0 = *(const f32x4*)(gain + (lane & 7) * 8), g1 = *(const f32x4*)(gain + (lane & 7) * 8 + 4);
    x[0] *= r * g0.x; x[1] *= r * g0.y; x[2] *= r * g0.z; x[3] *= r * g0.w; x[4] *= r * g1.x; x[5] *= r * g1.y; x[6] *= r * g1.z; x[7] *= r * g1.w;
    if (rope) { const f32x4 c0 = *(const f32x4*)(rp + (lane & 7) * 8), c1 = *(const f32x4*)(rp + (lane & 7) * 8 + 4);
        float t0;
        t0 = x[0] * c0.x - x[1] * c0.y; x[1] = x[0] * c0.y + x[1] * c0.x; x[0] = t0;
        t0 = x[2] * c0.z - x[3] * c0.w; x[3] = x[2] * c0.w + x[3] * c0.z; x[2] = t0;
        t0 = x[4] * c1.x - x[5] * c1.y; x[5] = x[4] * c1.y + x[5] * c1.x; x[4] = t0;
        t0 = x[6] * c1.z - x[7] * c1.w; x[7] = x[6] * c1.w + x[7] * c1.z; x[6] = t0; }
    if (isq) {
#pragma unroll
        for (int e = 0; e < 8; ++e) x[e] *= QSCALE; }
    v4u o; o.x = pk2(x[0], x[1]); o.y = pk2(x[2], x[3]); o.z = pk2(x[4], x[5]); o.w = pk2(x[6], x[7]); return o;
}
__device__ __forceinline__ void qknorm_phase(Frame& F0, const Args& a, int l, bf16* U, int dry = 0) {
    Frame F = F0; { int t_ = F0.wave0 * 64 + lane_asm(); asm volatile("" : "+v"(t_)); F.tid = t_; F.lane = t_ & 63; F.wave = __builtin_amdgcn_readfirstlane(t_ >> 6); } int lz = 0; asm volatile("" : "+s"(lz)); unsigned char* wsl = (unsigned char*)((unsigned long long)a.ws ^ (unsigned long long)(unsigned)lz);
    const int even = !(l & 1), i = l >> 1, pitch = even ? NIN_E : NIN_O;
    const float* ROPE = (const float*)(wsl + WS_ROPE);
    const int gw = F.bid * NWAVES + F.wave, NGW = F.G * NWAVES;
    if (even) {
        const float *g0 = a.in[lz + I_NAQG] + i * 64, *g1 = a.in[lz + I_NAKG] + i * 64, *g2 = a.in[lz + I_DAQG] + i * 64, *g3 = a.in[lz + I_DAKG] + i * 64;
        for (int row = gw; row < MROWS; row += 2 * NGW) {
            const int row1 = row + NGW; const bool has1 = row1 < MROWS;
            bf16* u0 = U + (size_t)row * pitch + F.lane * 8; bf16* u1 = U + (size_t)(has1 ? row1 : row) * pitch + F.lane * 8;
            const v4u a0 = *(const v4u*)u0, a1 = *(const v4u*)(u0 + 512), a2 = *(const v4u*)(u0 + 1536), a3 = *(const v4u*)(u0 + 2048);
            const v4u b0 = *(const v4u*)u1, b1 = *(const v4u*)(u1 + 512), b2 = *(const v4u*)(u1 + 1536), b3 = *(const v4u*)(u1 + 2048);
            const int t0 = row % TPB, t1 = (has1 ? row1 : row) % TPB; const bool l0 = t0 < SEQ, l1 = t1 < SEQ;
            const float* rp0 = ROPE + (size_t)(l0 ? t0 : 0) * 64; const float* rp1 = ROPE + (size_t)(l1 ? t1 : 0) * 64;
            const v4u o0 = qk_compute(a0, g0, true, false, rp0, F.lane), o1 = qk_compute(a1, g1, false, false, rp0, F.lane), o2 = qk_compute(a2, g2, true, l0, rp0, F.lane), o3 = qk_compute(a3, g3, false, l0, rp0, F.lane);
            const v4u p0 = qk_compute(b0, g0, true, false, rp1, F.lane), p1 = qk_compute(b1, g1, false, false, rp1, F.lane), p2 = qk_compute(b2, g2, true, l1, rp1, F.lane), p3 = qk_compute(b3, g3, false, l1, rp1, F.lane);
            if (dry && (o0.x ^ o1.x ^ o2.x ^ o3.x ^ p0.x ^ p1.x ^ p2.x ^ p3.x) != 0x12345678u) continue;
            *(v4u*)u0 = o0; *(v4u*)(u0 + 512) = o1; *(v4u*)(u0 + 1536) = o2; *(v4u*)(u0 + 2048) = o3;
            if (has1) { *(v4u*)u1 = p0; *(v4u*)(u1 + 512) = p1; *(v4u*)(u1 + 1536) = p2; *(v4u*)(u1 + 2048) = p3; }
        }
    } else {
        const float *g0 = a.in[lz + I_GQG] + i * 64, *g1 = a.in[lz + I_GKG] + i * 64;
        const bool kact = F.lane < 16;
        for (int row = gw; row < MROWS; row += 2 * NGW) {
            const int row1 = row + NGW; const bool has1 = row1 < MROWS;
            bf16* u0 = U + (size_t)row * pitch + F.lane * 8; bf16* u1 = U + (size_t)(has1 ? row1 : row) * pitch + F.lane * 8;
            const v4u zero = {0u, 0u, 0u, 0u};
            const v4u a0 = *(const v4u*)u0, a1 = kact ? *(const v4u*)(u0 + 512) : zero;
            const v4u b0 = *(const v4u*)u1, b1 = kact ? *(const v4u*)(u1 + 512) : zero;
            const int t0 = row % TPB, t1 = (has1 ? row1 : row) % TPB; const bool l0 = t0 < SEQ, l1 = t1 < SEQ;
            const float* rp0 = ROPE + (size_t)(l0 ? t0 : 0) * 64; const float* rp1 = ROPE + (size_t)(l1 ? t1 : 0) * 64;
            const v4u o0 = qk_compute(a0, g0, true, l0, rp0, F.lane), o1 = qk_compute(a1, g1, false, l0, rp0, F.lane);
            const v4u p0 = qk_compute(b0, g0, true, l1, rp1, F.lane), p1 = qk_compute(b1, g1, false, l1, rp1, F.lane);
            if (dry && (o0.x ^ o1.x ^ p0.x ^ p1.x) != 0x12345678u) continue;
            *(v4u*)u0 = o0; if (kact) *(v4u*)(u0 + 512) = o1;
            if (has1) { *(v4u*)u1 = p0; if (kact) *(v4u*)(u1 + 512) = p1; }
        }
    }
}
__device__ __forceinline__ void hyprep_phase(Frame& F0, const Args& a, int l, const bf16* U) {
    Frame F = F0; { int t_ = F0.wave0 * 64 + lane_asm(); asm volatile("" : "+v"(t_)); F.tid = t_; F.lane = t_ & 63; F.wave = __builtin_amdgcn_readfirstlane(t_ >> 6); } int lz = 0; asm volatile("" : "+s"(lz)); unsigned char* wsl = (unsigned char*)((unsigned long long)a.ws ^ (unsigned long long)(unsigned)lz);
    const int i = l >> 1;
    bf16* ZT = (bf16*)(wsl + WS_ZT); bf16* X0T = (bf16*)(wsl + WS_X0T);
    LAS bf16* zs = (LAS bf16*)F.lds; LAS bf16* xs = zs + 128 * 66;
    if (F.bid == (F.G > 1 ? 1 : 0)) { float* INV = (float*)(wsl + WS_PART) + 132 * 512; const float* PART = (const float*)(wsl + WS_PART);
        { float s = 0.f; for (int k = 0; k < 128; ++k) s += PART[(size_t)k * 512 + F.tid]; INV[F.tid] = 1.0f / s; }
        if (l == 1) { float s = 0.f; for (int k = 0; k < 4; ++k) s += PART[(size_t)(128 + k) * 512 + F.tid]; INV[512 + F.tid] = 1.0f / s; } }
    const float* cw = a.in[lz + I_HCW] + (size_t)i * 3 * 1536; const float* cb = a.in[lz + I_HCB] + (size_t)i * 1536;
    const int cp = F.tid & 63, tq = F.tid >> 6;
    for (int it = F.bid; it < 2048; it += F.G) {
        const int cgp = it & 3, tile = it >> 2, b = tile >> 7, t0 = (tile & 127) * 64;
        const size_t rowb = (size_t)b * TPB;
        const int tb = t0 + tq * 8;
        float res[3][8][2];
#pragma unroll
        for (int part = 0; part < 3; ++part) {
            const int cc = part * 512 + cgp * 128 + 2 * cp;
            const float w0a = cw[cc], w0b = cw[cc + 1], w1a = cw[1536 + cc], w1b = cw[1536 + cc + 1], w2a = cw[3072 + cc], w2b = cw[3072 + cc + 1], ba = cb[cc], bb = cb[cc + 1];
            unsigned ua[10];
#pragma unroll
            for (int k = 0; k < 10; ++k) { const int tt = tb - 1 + k; ua[k] = (tt >= 0 && tt < SEQ) ? *(const unsigned*)(U + (rowb + tt) * NIN_O + 768 + cc) : 0u; }
#pragma unroll
            for (int k = 0; k < 8; ++k) { res[part][k][0] = w0a * bflo(ua[k]) + w1a * bflo(ua[k + 1]) + w2a * bflo(ua[k + 2]) + ba;
                                          res[part][k][1] = w0b * bfhi(ua[k]) + w1b * bfhi(ua[k + 1]) + w2b * bfhi(ua[k + 2]) + bb; }
        }
#pragma unroll
        for (int k = 0; k < 8; ++k) {
            zs[(2 * cp) * 66 + tq * 8 + k] = (bf16)f2bf(res[2][k][0] * res[1][k][0]); zs[(2 * cp + 1) * 66 + tq * 8 + k] = (bf16)f2bf(res[2][k][1] * res[1][k][1]);
            xs[(2 * cp) * 66 + tq * 8 + k] = (bf16)f2bf(res[0][k][0]);               xs[(2 * cp + 1) * 66 + tq * 8 + k] = (bf16)f2bf(res[0][k][1]);
        }
        __syncthreads();
        { const int c = F.tid >> 2, q = F.tid & 3; const size_t go = (size_t)(cgp * 128 + c) * (NBATCH * SEQ) + (size_t)b * SEQ + t0 + q * 16;
          const LAS unsigned* zr = (const LAS unsigned*)(zs + c * 66 + q * 16); const LAS unsigned* xr = (const LAS unsigned*)(xs + c * 66 + q * 16);
          v4u z0 = {zr[0], zr[1], zr[2], zr[3]}, z1 = {zr[4], zr[5], zr[6], zr[7]}, x0 = {xr[0], xr[1], xr[2], xr[3]}, x1 = {xr[4], xr[5], xr[6], xr[7]};
          *(v4u*)(ZT + go) = z0; *(v4u*)(ZT + go + 8) = z1; *(v4u*)(X0T + go) = x0; *(v4u*)(X0T + go + 8) = x1; }
        __syncthreads();
    }
}

struct DenseMap { static constexpr bool HAS_MASK = false;
    __device__ __forceinline__ int row(int t) const { return 64 * t; }
    __device__ __forceinline__ void mask(f32x16&, f32x16&, int, int, int) const {} };
struct NaMap { static constexpr bool HAS_MASK = true; int rlo, qr0; const LAS float* tab;
    __device__ __forceinline__ int row(int t) const { const int kr = rlo + t - 4; return t < 4 ? SEQ + 64 * t : (kr > 127 ? 127 : kr) * 64; }
    __device__ __forceinline__ void mask(f32x16& p0, f32x16& p1, int t, int qrel, int hi) const {
        if (t < 4) return;
        const int kr = rlo + t - 4, qr = qr0 + (qrel >> 6), r0q = (qr - 4 < 0) ? 0 : (qr - 4 > 120 ? 120 : qr - 4);
        const bool rowok = (kr >= r0q) && (kr <= r0q + 7);
        const int qc = qrel & 63, c0 = (qc - 8 < 0) ? 0 : (qc - 8 > 48 ? 48 : qc - 8);
        const float NEG = -INFINITY;
        if (!rowok) {
#pragma unroll
            for (int r = 0; r < 16; ++r) { p0[r] = NEG; p1[r] = NEG; }
        } else {
            const LAS float* tb = tab + (kr - qr + 7) * 31 + 15 - qc;
#pragma unroll
            for (int r = 0; r < 16; ++r) { const int kc = (r & 3) + 8 * (r >> 2) + 4 * hi;
                const bool ok0 = (unsigned)(kc - c0) < 16u, ok1 = (unsigned)(kc + 32 - c0) < 16u;
                const float b0 = tb[kc], b1 = tb[kc + 32];
                p0[r] = ok0 ? p0[r] + b0 : NEG; p1[r] = ok1 ? p1[r] + b1 : NEG; }
        }
    } };

__device__ __forceinline__ int q_next(Frame& F, unsigned* ctr, int x, int nloc) {
    volatile LAS int* w = (volatile LAS int*)(F.lds + MISC_OFF);
    __syncthreads();
    if (F.tid == 0) { int res = -1;
        for (int k = 0; k < 8; ++k) { const int xx = (x + k) & 7; const unsigned n = atomicAdd(ctr + xx * 64, 1u); if (n < (unsigned)nloc) { res = xx * 65536 + (int)n; break; } }
        w[0] = res; }
    __syncthreads();
    return __builtin_amdgcn_readfirstlane(w[0]);
}

__device__ __forceinline__ void hyena_unit(Frame& F0, const Args& a, int l, int c, int dry) {
    Frame F = F0; { int t_ = F0.wave0 * 64 + lane_asm(); asm volatile("" : "+v"(t_)); F.tid = t_; F.lane = t_ & 63; F.wave = __builtin_amdgcn_readfirstlane(t_ >> 6); } int lz = 0; asm volatile("" : "+s"(lz)); unsigned char* wsl = (unsigned char*)((unsigned long long)a.ws ^ (unsigned long long)(unsigned)lz);
    const int i = l >> 1;
    const float* FILT = (const float*)(wsl + WS_FILT) + (size_t)c * 16384;
    const bf16* ZT = (const bf16*)(wsl + WS_ZT) + (size_t)c * (NBATCH * SEQ); bf16* X0T = (bf16*)(wsl + WS_X0T) + (size_t)c * (NBATCH * SEQ);
    const float inv = ((const float*)(wsl + WS_PART) + 132 * 512)[c];
    const float skipc = a.in[lz + I_HSKIP][i * 512 + c];
    LAS bf16* RA = (LAS bf16*)F.lds;
    LAS bf16* RB = (LAS bf16*)(F.lds + 32768 + 64);
    LAS bf16* zl = (LAS bf16*)(F.lds + 65536 + 64);
#define HY_ZIDX(bq_, t_) ((bq_) * 8736 + ((t_) >> 7) * 136 + ((t_) & 127))
    f32x4 fv[4], fw[4]; v4u zq[8];
#pragma unroll
    for (int q = 0; q < 4; ++q) { const int j = F.tid * 4 + q * NTHREADS * 4; fv[q] = *(const f32x4*)(FILT + j); fw[q] = *(const f32x4*)(FILT + 8192 + j); }
#pragma unroll
    for (int q = 0; q < 8; ++q) zq[q] = *(const v4u*)(ZT + F.tid * 8 + q * NTHREADS * 8);
#pragma unroll
    for (int q = 0; q < 4; ++q) { const int j = F.tid * 4 + q * NTHREADS * 4; const f32x4 vf = fv[q], vb = fw[q];
        const float ff[4] = {vf.x, vf.y, vf.z, vf.w}, fb[4] = {vb.x, vb.y, vb.z, vb.w};
#pragma unroll
        for (int e = 0; e < 4; ++e) { const int pp = j + e; const bf16 hf = (bf16)f2bf(ff[e] * inv), hb = (bf16)f2bf(fb[e] * inv);
            RA[8191 - pp] = hf; if (8191 - pp >= 1) RB[8190 - pp] = hf;
            if (pp >= 1) { RA[8191 + pp] = hb; RB[8190 + pp] = hb; } } }
#pragma unroll
    for (int q = 0; q < 8; ++q) { const int j = F.tid * 8 + q * NTHREADS * 8; *(LAS v4u*)(zl + HY_ZIDX(j >> 13, j & 8191)) = zq[q]; }
    __syncthreads();
    const int w = F.wave, n = F.lane & 31, kg = F.lane >> 5, ii = 8 * w + (n >> 2), bb = n & 3;
    const unsigned abase = (n & 1) ? (unsigned)(uintptr_t)(RA + (8191 - n + 8 * kg)) : (unsigned)(uintptr_t)(RB + (8190 - n + 8 * kg));
    f32x16 acc[4];
#pragma unroll
    for (int m = 0; m < 4; ++m) acc[m] = f32x16{};
    v2u af[14][2], an[8][2]; v4u bq[8], bn[8];
#define HY_LDA(dst, g, addr) do { asm volatile("ds_read2_b32 %0, %1 offset0:%2 offset1:%3" : "=v"(dst[0]) : "v"(addr), "n"(104 - 8 * (g)), "n"(105 - 8 * (g)) : "memory"); \
                                  asm volatile("ds_read2_b32 %0, %1 offset0:%2 offset1:%3" : "=v"(dst[1]) : "v"(addr), "n"(106 - 8 * (g)), "n"(107 - 8 * (g)) : "memory"); } while (0)
#define HY_LDB(dst, ks, zaddr) asm volatile("ds_read_b128 %0, %1 offset:%2" : "=v"(dst) : "v"(zaddr), "n"((ks) * 32) : "memory")
#define HY_ISSUE(dd) do { const unsigned addr_ = abase + (unsigned)((-64 * (dd) - 48) * 4);     \
        HY_LDA(an[0], 6, addr_); HY_LDA(an[1], 7, addr_); HY_LDA(an[2], 8, addr_); HY_LDA(an[3], 9, addr_); HY_LDA(an[4], 10, addr_); HY_LDA(an[5], 11, addr_); HY_LDA(an[6], 12, addr_); HY_LDA(an[7], 13, addr_); \
        const int jb_ = ii - (dd); const unsigned zaddr_ = (unsigned)(uintptr_t)(zl + bb * 8736 + ((unsigned)jb_ < 64u ? jb_ : 0) * 136 + kg * 8); \
        HY_LDB(bn[0], 0, zaddr_); HY_LDB(bn[1], 1, zaddr_); HY_LDB(bn[2], 2, zaddr_); HY_LDB(bn[3], 3, zaddr_); HY_LDB(bn[4], 4, zaddr_); HY_LDB(bn[5], 5, zaddr_); HY_LDB(bn[6], 6, zaddr_); HY_LDB(bn[7], 7, zaddr_); } while (0)
    const int d0 = 8 * w - 63, dlast = 8 * w + 7;
    { const unsigned addr = abase + (unsigned)((-64 * d0 - 48) * 4);
      HY_LDA(af[8], 0, addr); HY_LDA(af[9], 1, addr); HY_LDA(af[10], 2, addr); HY_LDA(af[11], 3, addr); HY_LDA(af[12], 4, addr); HY_LDA(af[13], 5, addr); }
    HY_ISSUE(d0);
    for (int d = d0; d <= dlast; ++d) {
        asm volatile("s_waitcnt lgkmcnt(0)" ::: "memory");
#pragma unroll
        for (int g = 8; g < 14; ++g) asm volatile("" : "+v"(af[g][0]), "+v"(af[g][1]));
#pragma unroll
        for (int g = 0; g < 8; ++g) asm volatile("" : "+v"(an[g][0]), "+v"(an[g][1]), "+v"(bn[g]));
#pragma unroll
        for (int g = 0; g < 6; ++g) { af[g][0] = af[g + 8][0]; af[g][1] = af[g + 8][1]; }
#pragma unroll
        for (int g = 0; g < 8; ++g) { af[6 + g][0] = an[g][0]; af[6 + g][1] = an[g][1]; bq[g] = bn[g]; }
#pragma unroll
        for (int g = 0; g < 14; ++g) asm volatile("" : "+v"(af[g][0]), "+v"(af[g][1]));
#pragma unroll
        for (int g = 0; g < 8; ++g) asm volatile("" : "+v"(bq[g]));
        if (d < dlast) HY_ISSUE(d + 1);
        const int jb = ii - d; const bool valid = (unsigned)jb < 64u;
#pragma unroll
        for (int ks = 0; ks < 8; ++ks) {
            bf16x8 bfr = __builtin_bit_cast(bf16x8, bq[ks]);
            if (!valid) bfr = bf16x8{};
#pragma unroll
            for (int mt = 0; mt < 4; ++mt) { const int g = 2 * mt - ks + 7; const v4u aw = {af[g][0].x, af[g][0].y, af[g][1].x, af[g][1].y};
                acc[mt] = __builtin_amdgcn_mfma_f32_32x32x16_bf16(__builtin_bit_cast(bf16x8, aw), bfr, acc[mt], 0, 0, 0); }
        }
    }
#undef HY_LDA
#undef HY_LDB
#undef HY_ISSUE
    __syncthreads();
    LAS bf16* yt = (LAS bf16*)F.lds + w * 4096;
#pragma unroll
    for (int mt = 0; mt < 4; ++mt)
#pragma unroll
        for (int v = 0; v < 16; ++v) { const int tl = (n >> 2) * 128 + 32 * mt + (v & 3) + 8 * (v >> 2) + 4 * kg; yt[bb * 1024 + (tl & ~127) + ((((tl & 127) >> 3) ^ (n >> 2)) << 3) + (tl & 7)] = (bf16)f2bf(acc[mt][v]); }
    LDS_WAIT();
#pragma unroll
    for (int it = 0; it < 8; ++it) { const int e = (it * 64 + F.lane) * 8, b2 = e >> 10, tl = e & 1023; const size_t go = (size_t)b2 * SEQ + 1024 * w + tl;
        const v4u xv = *(const v4u*)(X0T + go), zv = *(const LAS v4u*)(zl + HY_ZIDX(b2, 1024 * w + tl)), yv = *(const LAS v4u*)(yt + (e & ~127) + ((((e & 127) >> 3) ^ ((e >> 7) & 7)) << 3));
        const unsigned xa[4] = {xv.x, xv.y, xv.z, xv.w}, za[4] = {zv.x, zv.y, zv.z, zv.w}, ya[4] = {yv.x, yv.y, yv.z, yv.w}; unsigned oo[4];
#pragma unroll
        for (int q = 0; q < 4; ++q) oo[q] = pk2(bflo(xa[q]) * (bflo(ya[q]) + skipc * bflo(za[q])), bfhi(xa[q]) * (bfhi(ya[q]) + skipc * bfhi(za[q])));
        if (dry && oo[0] != 0x12345678u) { oo[0] = xa[0]; oo[1] = xa[1]; oo[2] = xa[2]; oo[3] = xa[3]; }
        *(v4u*)(X0T + go) = (v4u){oo[0], oo[1], oo[2], oo[3]}; }
}
#undef HY_ZIDX

__device__ __forceinline__ void hyena_ctx_item(Frame& F0, const Args& a, int l, int item, const bf16* U) {
    Frame F = F0; { int t_ = F0.wave0 * 64 + lane_asm(); asm volatile("" : "+v"(t_)); F.tid = t_; F.lane = t_ & 63; F.wave = __builtin_amdgcn_readfirstlane(t_ >> 6); } int lz = 0; asm volatile("" : "+s"(lz)); unsigned char* wsl = (unsigned char*)((unsigned long long)a.ws ^ (unsigned long long)(unsigned)lz);
    const int i = l >> 1, c = item * 8 + F.wave, lane = F.lane;
    LAS float* fl = (LAS float*)(F.lds + F.wave * 16384);
    LAS float* zl = fl + 512;
    LAS float* xl = zl + 1024;
    const float* FILTC = (const float*)(wsl + WS_FILTC) + (size_t)c * 512;
    const float inv = ((const float*)(wsl + WS_PART) + 132 * 512 + 512)[c];
    const float skipc = a.in[lz + I_HSKIP][i * 512 + c];
    bf16* YTC = (bf16*)(wsl + WS_YTC) + (size_t)c * 1024;
    const float* cw = a.in[lz + I_HCW] + (size_t)i * 3 * 1536; const float* cb = a.in[lz + I_HCB] + (size_t)i * 1536;
    for (int j = lane; j < 256; j += 64) { fl[255 + j] = FILTC[j] * inv; if (j > 0) fl[255 - j] = FILTC[256 + j] * inv; }
    if (lane == 0) fl[511] = 0.f;
    for (int b = 0; b < 4; ++b)
        for (int k = 0; k < 4; ++k) { const int t = lane + 64 * k; float r3[3];
#pragma unroll
            for (int part = 0; part < 3; ++part) { const int cc = part * 512 + c; const bf16* up = U + ((size_t)b * TPB + SEQ + t) * NIN_O + 768 + cc;
                const float um = t > 0 ? bf2f(up[-NIN_O]) : 0.f, u0 = bf2f(up[0]), u1 = t < 255 ? bf2f(up[NIN_O]) : 0.f;
                r3[part] = cw[cc] * um + cw[1536 + cc] * u0 + cw[3072 + cc] * u1 + cb[cc]; }
            zl[b * 256 + t] = r3[2] * r3[1]; xl[b * 256 + t] = r3[0]; }
    LDS_WAIT();
    for (int k = 0; k < 4; ++k) { const int t = lane + 64 * k; float y0 = 0.f, y1 = 0.f, y2 = 0.f, y3 = 0.f;
        for (int s = 0; s < 256; ++s) { const float f = fl[t - s + 255]; y0 += f * zl[s]; y1 += f * zl[256 + s]; y2 += f * zl[512 + s]; y3 += f * zl[768 + s]; }
        const float yy[4] = {y0, y1, y2, y3};
#pragma unroll
        for (int b = 0; b < 4; ++b) YTC[b * 256 + t] = (bf16)f2bf(xl[b * 256 + t] * (yy[b] + skipc * zl[b * 256 + t])); }
}

__device__ __forceinline__ void mixer_phase(Frame& F0, const Args& a, int l, char* ldsg, int qslot, int dry) {
    Frame F = F0; { int t_ = F0.wave0 * 64 + lane_asm(); asm volatile("" : "+v"(t_)); F.tid = t_; F.lane = t_ & 63; F.wave = __builtin_amdgcn_readfirstlane(t_ >> 6); } int lz = 0; asm volatile("" : "+s"(lz)); unsigned char* wsl = (unsigned char*)((unsigned long long)a.ws ^ (unsigned long long)(unsigned)lz);
    using abf = attn_body::bf16;
    const int even = !(l & 1), i = l >> 1;
    unsigned* ctr = (unsigned*)(wsl + WS_CTL) + CW_QUEUE + 512 * qslot;
    const int xcd = (int)(xb_xcc_id() & 7u);
    const bf16* U = (const bf16*)(wsl + WS_U); bf16* MIX = (bf16*)(wsl + WS_H); bf16* DAO = (bf16*)(wsl + WS_DAO);
    const int nloc = even ? 396 : (l == 1 ? 204 : 196);
    LAS float* tab = (LAS float*)(F.lds + 86016);
    for (;;) {
        const int qv = q_next(F, ctr, xcd, nloc);
        if (qv < 0) break;
        int id; { const int xx = qv >> 16, n = qv & 65535;
            if (even) { if (n < 256) id = (8 * (n >> 5) + xx) * 32 + (n & 31);
                        else if (n < 384) id = 2048 + (8 * ((n - 256) >> 5) + xx) * 32 + (n & 31);
                        else if (n < 392) id = 3072 + 8 * (n - 384) + xx;
                        else id = 3136 + 8 * (n - 392) + xx; }
            else { if (n < 128) { const int m = n, b = xx >> 1, h = (xx & 1) * 4 + (m >> 5); id = 512 + (b * 8 + h) * 32 + (m & 31); }
                   else if (n < 192) id = 8 * (n - 128) + xx;
                   else if (n < 196) { const int b = xx >> 1, h = (xx & 1) * 4 + (n - 192); id = 1536 + b * 8 + h; }
                   else id = 1568 + 8 * (n - 196) + xx; } }
        const bf16 *Q, *K, *V; bf16* O; int pin, NT = 132, po = 1024; bool isna = false; int na_qb = 0, na_h = 0;
        if (even) {
            pin = NIN_E;
            if (id < 2048) { const int qb = id & 31, x = id >> 5, half = x & 1, comp = (x >> 1) & 1, hd = (x >> 2) & 3, b = x >> 4; const size_t rb = (size_t)b * TPB;
                Q = U + (rb + qb * 256) * NIN_E + 1536 + (2 * hd + comp) * 64; K = U + rb * NIN_E + 2048 + (2 * hd + comp) * 64; V = U + rb * NIN_E + 2560 + hd * 128 + half * 64;
                O = DAO + (rb + qb * 256) * 1024 + ((hd * 2 + comp) * 2 + half) * 64; }
            else if (id < 3072) { const int y = id - 2048, qb = y & 31, h = (y >> 5) & 7, b = y >> 8; const size_t rb = (size_t)b * TPB;
                Q = U + (rb + qb * 256) * NIN_E + h * 64; K = U + rb * NIN_E + 512 + h * 64; V = U + rb * NIN_E + 1024 + h * 64; O = MIX + (rb + qb * 256) * 1024 + h * 64;
                NT = 16; isna = true; na_qb = qb; na_h = h; }
            else if (id < 3136) { const int x = id - 3072, half = x & 1, comp = (x >> 1) & 1, hd = (x >> 2) & 3, b = x >> 4; const size_t rb = (size_t)b * TPB + SEQ;
                Q = U + rb * NIN_E + 1536 + (2 * hd + comp) * 64; K = U + rb * NIN_E + 2048 + (2 * hd + comp) * 64; V = U + rb * NIN_E + 2560 + hd * 128 + half * 64;
                O = DAO + rb * 1024 + ((hd * 2 + comp) * 2 + half) * 64; NT = 4; }
            else { const int x = id - 3136, h = x & 7, b = x >> 3; const size_t rb = (size_t)b * TPB + SEQ;
                Q = U + rb * NIN_E + h * 64; K = U + rb * NIN_E + 512 + h * 64; V = U + rb * NIN_E + 1024 + h * 64; O = MIX + rb * 1024 + h * 64; NT = 4; }
        } else {
            pin = NIN_O;
            if (id < 512) {
#ifndef NO_HYU
 hyena_unit(F, a, l, id, dry);
#endif
 continue; }
            else if (id < 1536) { const int y = id - 512, qb = y & 31, h = (y >> 5) & 7, b = y >> 8; const size_t rb = (size_t)b * TPB;
                Q = U + (rb + qb * 256) * NIN_O + h * 64; K = U + rb * NIN_O + 512 + (h >> 2) * 64; V = U + rb * NIN_O + 640 + (h >> 2) * 64; O = MIX + (rb + qb * 256) * 1024 + h * 64; }
            else if (id < 1568) { const int x = id - 1536, h = x & 7, b = x >> 3; const size_t rb = (size_t)b * TPB + SEQ;
                Q = U + rb * NIN_O + h * 64; K = U + rb * NIN_O + 512 + (h >> 2) * 64; V = U + rb * NIN_O + 640 + (h >> 2) * 64; O = MIX + rb * 1024 + h * 64; NT = 4; }
            else {
#ifndef NO_HYC
 hyena_ctx_item(F, a, l, id - 1568, U);
#endif
 continue; }
        }
        if (isna) {
            const float* rpb = a.in[lz + I_RPB] + ((size_t)i * 8 + na_h) * 465;
            { int t2 = F.tid; asm volatile("" : "+v"(t2)); if (t2 < 465) tab[t2] = rpb[t2] * 1.4426950408889634f; }
            NaMap tm; const int r4 = 4 * na_qb; tm.rlo = (r4 - 4 < 0) ? 0 : (r4 - 4 > 120 ? 120 : r4 - 4); tm.qr0 = r4; tm.tab = tab;
#ifndef NO_NA
            attn_body::attn_unit<8, NaMap>((const abf*)Q, pin, (const abf*)K, pin, (const abf*)V, pin, (abf*)O, po, NT, tm, ldsg, F0.wave0);
#endif
        } else {
            DenseMap tm;
#ifndef NO_DENSE
            attn_body::attn_unit<8, DenseMap>((const abf*)Q, pin, (const abf*)K, pin, (const abf*)V, pin, (abf*)O, po, NT, tm, ldsg, F0.wave0);
#endif
        }
    }
}

__device__ __forceinline__ void hypost_phase(Frame& F0, const Args& a, int l) {
    Frame F = F0; { int t_ = F0.wave0 * 64 + lane_asm(); asm volatile("" : "+v"(t_)); F.tid = t_; F.lane = t_ & 63; F.wave = __builtin_amdgcn_readfirstlane(t_ >> 6); } int lz = 0; asm volatile("" : "+s"(lz)); unsigned char* wsl = (unsigned char*)((unsigned long long)a.ws ^ (unsigned long long)(unsigned)lz);
    const bf16* YT = (const bf16*)(wsl + WS_X0T); const bf16* YTC = (const bf16*)(wsl + WS_YTC); bf16* MIX = (bf16*)(wsl + WS_H);
    LAS bf16* zs = (LAS bf16*)F.lds;
    const int ntile = 512 + (l == 1 ? 16 : 0);
    for (int it = F.bid; it < ntile * 4; it += F.G) {
        const int cgp = it & 3, tile = it >> 2;
        const bf16* src; size_t row0; int cstride;
        if (tile < 512) { const int b = tile >> 7, t0 = (tile & 127) * 64; src = YT + (size_t)b * SEQ + t0; cstride = NBATCH * SEQ; row0 = (size_t)b * TPB + t0; }
        else { const int x = tile - 512, b = x >> 2, t0 = (x & 3) * 64; src = YTC + b * 256 + t0; cstride = 1024; row0 = (size_t)b * TPB + SEQ + t0; }
        { const int c = F.tid >> 2, q = F.tid & 3; const bf16* sp = src + (size_t)(cgp * 128 + c) * cstride + q * 16;
          const v4u a0 = *(const v4u*)sp, a1 = *(const v4u*)(sp + 8); LAS unsigned* d = (LAS unsigned*)(zs + c * 66 + q * 16);
          d[0] = a0.x; d[1] = a0.y; d[2] = a0.z; d[3] = a0.w; d[4] = a1.x; d[5] = a1.y; d[6] = a1.z; d[7] = a1.w; }
        __syncthreads();
        { const int cp = F.tid & 63, tq = F.tid >> 6;
#pragma unroll
          for (int k = 0; k < 8; ++k) { const int t = tq * 8 + k; const unsigned lo = zs[(2 * cp) * 66 + t], hi = zs[(2 * cp + 1) * 66 + t];
              *(unsigned*)(MIX + (row0 + t) * 1024 + 512 + cgp * 128 + 2 * cp) = lo | (hi << 16); } }
        __syncthreads();
    }
}

__device__ __forceinline__ void dacombine_phase(Frame& F0, const Args& a, int l) {
    Frame F = F0; { int t_ = F0.wave0 * 64 + lane_asm(); asm volatile("" : "+v"(t_)); F.tid = t_; F.lane = t_ & 63; F.wave = __builtin_amdgcn_readfirstlane(t_ >> 6); } int lz = 0; asm volatile("" : "+s"(lz)); unsigned char* wsl = (unsigned char*)((unsigned long long)a.ws ^ (unsigned long long)(unsigned)lz);
    const int i = l >> 1; const float lam_init = 0.8f - 0.6f * expf(-0.3f * (float)l);
    const float s1 = wave_sum(a.in[lz + I_LQ1][i * 64 + F.lane] * a.in[lz + I_LK1][i * 64 + F.lane], F.lane), s2 = wave_sum(a.in[lz + I_LQ2][i * 64 + F.lane] * a.in[lz + I_LK2][i * 64 + F.lane], F.lane);
    const float lam = expf(s1) - expf(s2) + lam_init;
    const bf16* DAO = (const bf16*)(wsl + WS_DAO); bf16* MIX = (bf16*)(wsl + WS_H);
    const int hd = F.lane >> 4, d = (F.lane & 15) * 8, half = d >> 6, dd = d & 63;
    const float* sg = a.in[lz + I_SUBLN] + i * 128 + d;
    const f32x4 g0 = *(const f32x4*)sg, g1 = *(const f32x4*)(sg + 4);
    const float gg[8] = {g0.x, g0.y, g0.z, g0.w, g1.x, g1.y, g1.z, g1.w};
    const int gw = F.bid * NWAVES + F.wave, NGW = F.G * NWAVES;
    for (int row = gw; row < MROWS; row += NGW) {
        const v4u w1 = *(const v4u*)(DAO + (size_t)row * 1024 + ((hd * 2 + 0) * 2 + half) * 64 + dd), w2 = *(const v4u*)(DAO + (size_t)row * 1024 + ((hd * 2 + 1) * 2 + half) * 64 + dd);
        float y[8] = {bflo(w1.x) - lam * bflo(w2.x), bfhi(w1.x) - lam * bfhi(w2.x), bflo(w1.y) - lam * bflo(w2.y), bfhi(w1.y) - lam * bfhi(w2.y),
                      bflo(w1.z) - lam * bflo(w2.z), bfhi(w1.z) - lam * bfhi(w2.z), bflo(w1.w) - lam * bflo(w2.w), bfhi(w1.w) - lam * bfhi(w2.w)};
        float ss = 0.f;
#pragma unroll
        for (int e = 0; e < 8; ++e) ss += y[e] * y[e];
        ss += shfl_l(ss, F.lane ^ 1); ss += shfl_l(ss, F.lane ^ 2); ss += shfl_l(ss, F.lane ^ 4); ss += shfl_l(ss, F.lane ^ 8);
        const float r = (1.0f / sqrtf(ss * (1.f / 128.f) + EPS)) * (1.f - lam_init);
        v4u o; o.x = pk2(y[0] * r * gg[0], y[1] * r * gg[1]); o.y = pk2(y[2] * r * gg[2], y[3] * r * gg[3]); o.z = pk2(y[4] * r * gg[4], y[5] * r * gg[5]); o.w = pk2(y[6] * r * gg[6], y[7] * r * gg[7]);
        *(v4u*)(MIX + (size_t)row * 1024 + 512 + F.lane * 8) = o;
    }
}

__device__ __forceinline__ void convact_phase(Frame& F0, const Args& a, int l, int dry) {
    Frame F = F0; { int t_ = F0.wave0 * 64 + lane_asm(); asm volatile("" : "+v"(t_)); F.tid = t_; F.lane = t_ & 63; F.wave = __builtin_amdgcn_readfirstlane(t_ >> 6); } int lz = 0; asm volatile("" : "+s"(lz)); unsigned char* wsl = (unsigned char*)((unsigned long long)a.ws ^ (unsigned long long)(unsigned)lz);
    bf16* GV = (bf16*)(wsl + WS_GV);
    if (F.tid >= 352) return;
    const int j0 = F.tid * 8;
    const float* cw = a.in[lz + I_FCW] + (size_t)l * 3 * FFH + j0; const float* cb = a.in[lz + I_FCB] + (size_t)l * FFH + j0;
    float w0[8], w1[8], w2[8], bb[8];
#pragma unroll
    for (int e = 0; e < 8; ++e) { w0[e] = cw[e]; w1[e] = cw[FFH + e]; w2[e] = cw[2 * FFH + e]; bb[e] = cb[e]; }
    for (int it = F.bid; it < MROWS / 32; it += F.G) {
        const int r0 = it * 32, ts = r0 % TPB; const bool first = (ts == 0 || ts == SEQ), last = (ts + 32 == SEQ || ts + 32 == TPB);
#pragma unroll 1
        for (int rb = 0; rb < 32; rb += 8) {
            v4u gl[10], vl[8];
#pragma unroll
            for (int k = 0; k < 10; ++k) { const int r = rb - 1 + k; const bool zero = (r < 0 && first) || (r >= 32 && last);
                gl[k] = zero ? (v4u){0u, 0u, 0u, 0u} : *(const v4u*)(GV + (size_t)(r0 + r) * NUP + j0); }
#pragma unroll
            for (int k = 0; k < 8; ++k) vl[k] = *(const v4u*)(GV + (size_t)(r0 + rb + k) * NUP + FFH + j0);
#pragma unroll
            for (int k = 0; k < 8; ++k) {
                const unsigned gpa[4] = {gl[k].x, gl[k].y, gl[k].z, gl[k].w}, gca[4] = {gl[k + 1].x, gl[k + 1].y, gl[k + 1].z, gl[k + 1].w}, gna[4] = {gl[k + 2].x, gl[k + 2].y, gl[k + 2].z, gl[k + 2].w}, vva[4] = {vl[k].x, vl[k].y, vl[k].z, vl[k].w};
                unsigned oo[4];
#pragma unroll
                for (int q = 0; q < 4; ++q) {
                    const float ga = w0[2 * q] * bflo(gpa[q]) + w1[2 * q] * bflo(gca[q]) + w2[2 * q] * bflo(gna[q]) + bb[2 * q];
                    const float gb = w0[2 * q + 1] * bfhi(gpa[q]) + w1[2 * q + 1] * bfhi(gca[q]) + w2[2 * q + 1] * bfhi(gna[q]) + bb[2 * q + 1];
                    const float sa = ga / (1.f + __expf(-ga)), sb = gb / (1.f + __expf(-gb));
                    oo[q] = pk2(sa * bflo(vva[q]), sb * bfhi(vva[q])); }
                if (dry && oo[0] != 0x12345678u) { oo[0] = vva[0]; oo[1] = vva[1]; oo[2] = vva[2]; oo[3] = vva[3]; }
                *(v4u*)(GV + (size_t)(r0 + rb + k) * NUP + FFH + j0) = (v4u){oo[0], oo[1], oo[2], oo[3]};
            }
        }
    }
}
#ifdef PROBE_SYNC
#define GSYNC() do { xcd_barrier(xbar); xcd_barrier(xbar); } while (0)
#else
#define GSYNC() xcd_barrier(xbar)
#endif
#define GSYNC_CG() do { asm volatile("s_waitcnt vmcnt(0) lgkmcnt(0)" ::: "memory"); grid.sync(); __builtin_amdgcn_fence(__ATOMIC_ACQUIRE, "agent"); } while (0)
#if defined(NO_GEMM) || defined(NO_GEMM1)
#define GEMMCALL1 if (0)
#else
#define GEMMCALL1
#endif
#if defined(NO_GEMM) || defined(NO_GEMM2)
#define GEMMCALL2 if (0)
#else
#define GEMMCALL2
#endif
#if defined(NO_GEMM) || defined(NO_GEMM3)
#define GEMMCALL3 if (0)
#else
#define GEMMCALL3
#endif
#if defined(NO_GEMM) || defined(NO_GEMM4)
#define GEMMCALL4 if (0)
#else
#define GEMMCALL4
#endif
__global__ void __launch_bounds__(NTHREADS, 2) hybrid_fwd(Args a) {
    extern __shared__ __attribute__((aligned(16))) unsigned char lds[];
    cg::grid_group grid = cg::this_grid();
    Frame F;
    F.lds = (LAS unsigned char*)lds; F.tid = threadIdx.x; F.lane = F.tid & 63; F.wave = __builtin_amdgcn_readfirstlane(F.tid >> 6); F.G = gridDim.x; F.bid = blockIdx.x; F.wave0 = F.wave;

    { volatile LAS unsigned* misc = (volatile LAS unsigned*)(F.lds + MISC_OFF); if (F.tid < 32) misc[F.tid] = 0u; }
    __syncthreads();
    XcdBarrier xbar = xcd_barrier_post((unsigned*)(a.ws + WS_CTL) + CW_BAR, (volatile LAS unsigned*)(F.lds + MISC_OFF) + 8);
#ifndef NO_P0
    p0_prologue(F, a);
#endif
#ifdef PROBE_P0
    __syncthreads(); p0_prologue(F, a);
#endif

    { int never = 0; asm volatile("" : "+s"(never)); if (never) GSYNC_CG(); }
    GSYNC();
#define SITE() int lz = 0; asm volatile("" : "+s"(lz)); unsigned char* ws = (unsigned char*)((unsigned long long)a.ws ^ (unsigned long long)(unsigned)lz); (void)ws; \
    int bidl = F.bid; asm volatile("" : "+s"(bidl)); (void)bidl; \
    float* MODS = (float*)(ws + WS_MODS); float* XC = (float*)(ws + WS_XC); bf16* H = (bf16*)(ws + WS_H); bf16* U = (bf16*)(ws + WS_U); bf16* GV = (bf16*)(ws + WS_GV); \
    const float* xl_src = l == 0 ? a.in[lz + I_X] : a.out; const float* xc_src = l == 0 ? a.in[lz + I_CTX] : XC; const float* mods_l = MODS + (size_t)l * 5 * 6144; \
    (void)H; (void)U; (void)GV; (void)xl_src; (void)xc_src; (void)mods_l
#pragma nounroll
    for (int l = 0; l < 4; ++l) {
        const int even = !(l & 1);
        { SITE(); norm_phase(F, xl_src, xc_src, mods_l, 0, H); }
        weights_phase(F, a, l);
        __syncthreads();
        if (!even) filter_phase(F, a, l);
#ifdef PROBE_FILT
        if (!even) { __syncthreads(); filter_phase(F, a, l); }
#endif
        GSYNC();
        { SITE(); const int nin = even ? NIN_E : NIN_O; pg8::Gemm g{H, 1024, (const bf16*)(ws + WS_WIN), MROWS, nin, 1024}; pg8::StaticOrder S; S.init(MROWS, nin, F.G, bidl, even);
          EpiStore E{U, nin}; pg8::gemm_phase<EpiStore, pg8::StaticOrder, true, true>(F.lds, g, S, E, F.wave0);
          if (even) ctx_strip_gemm(F, H, 1024, (const bf16*)(ws + WS_WIN), 1024, nullptr, nullptr, nullptr, NIN_E / 64, U, NIN_E); }
        GSYNC();
#ifdef PROBE_QKN
        { SITE(); qknorm_phase(F, a, l, U, 1); }
#endif
        { SITE(); qknorm_phase(F, a, l, U); if (!even) hyprep_phase(F, a, l, U); }
        GSYNC();
#ifdef PROBE_MIXO
        for (int rep = 0; rep < (even ? 1 : 2); ++rep) { mixer_phase(F, a, l, (char*)lds, l + 4 * rep, (!even && rep == 0) ? 1 : 0); GSYNC(); }
#else
        mixer_phase(F, a, l, (char*)lds, l, 0);
        GSYNC();
#endif
        if (even) dacombine_phase(F, a, l); else hypost_phase(F, a, l);
        GSYNC();
        { SITE(); pg8::Gemm g{H, 1024, (const bf16*)(ws + WS_WOUT), MROWS, 1024, 1024}; pg8::StaticOrder S; S.init(MROWS, 1024, F.G, bidl, 1);
          EpiResid E{xl_src, xc_src, a.out, XC, mods_l + 2048};
#ifdef PROBE_GEMM2
          for (int rep = 0; rep < 2; ++rep) { int zi = rep; asm volatile("" : "+s"(zi)); E.mul = (float)zi; if (rep == 0) { E.dl = (float*)xl_src; E.dc = (float*)xc_src; } else { E.dl = a.out; E.dc = XC; } pg8::gemm_phase<EpiResid, pg8::StaticOrder, true, true>(F.lds, g, S, E, F.wave0); if (rep == 0) GSYNC(); }
#else
          pg8::gemm_phase<EpiResid, pg8::StaticOrder, true, true>(F.lds, g, S, E, F.wave0);
#endif
          if (l < 3) ctx_strip_gemm(F, H, 1024, (const bf16*)(ws + WS_WOUT), 1024, xc_src, XC, mods_l + 4 * 6144 + 2048); }
        GSYNC();
        { SITE(); norm_phase(F, a.out, XC, mods_l, 3072, H); }
        GSYNC();
        { SITE(); pg8::Gemm g{H - 1024, 1024, (const bf16*)(ws + WS_WUP), 137 * 256, NUP, 1024, 1}; pg8::StaticOrder S; S.init(137 * 256, NUP, F.G, bidl);
          EpiConv E{GV, a.in[lz + I_FCW] + (size_t)l * 3 * FFH, a.in[lz + I_FCB] + (size_t)l * FFH}; pg8::gemm_phase<EpiConv, pg8::StaticOrder, true, true>(F.lds, g, S, E, F.wave0); }
        GSYNC();
        { SITE(); pg8::Gemm g{GV, FFH, (const bf16*)(ws + WS_WDOWN), MROWS, 1024, FFH}; pg8::StaticOrder S; S.init(MROWS, 1024, F.G, bidl, 1);
          EpiResid E{a.out, XC, a.out, XC, mods_l + 5120};
#ifdef PROBE_GEMM2
          for (int rep = 0; rep < 2; ++rep) { int zi = rep; asm volatile("" : "+s"(zi)); E.mul = (float)zi; pg8::gemm_phase<EpiResid, pg8::StaticOrder, true, true>(F.lds, g, S, E, F.wave0); if (rep == 0) GSYNC(); }
#else
          pg8::gemm_phase<EpiResid, pg8::StaticOrder, true, true>(F.lds, g, S, E, F.wave0);
#endif
          if (l < 3) ctx_strip_gemm(F, GV, FFH, (const bf16*)(ws + WS_WDOWN), FFH, XC, XC, mods_l + 4 * 6144 + 5120); }
        GSYNC();
    }
}

extern "C" void kernel_launch(void* const* d_in, const int* in_sizes, int n_in, void* d_out, int out_size, void* d_ws, size_t ws_size, hipStream_t stream) {
    static int grid = 0;
    if (grid == 0) {
        if (n_in != 37 || out_size != NBATCH * SEQ * DMODEL || ws_size < WS_END) { fprintf(stderr, "kernel_launch: unexpected problem (n_in %d out %d ws %zu)\n", n_in, out_size, ws_size); grid = -1; return; }
        int dev = 0, cus = 0, per_cu = 0;
        if (hipGetDevice(&dev) != hipSuccess || hipDeviceGetAttribute(&cus, hipDeviceAttributeMultiprocessorCount, dev) != hipSuccess) { grid = -1; return; }
        if (hipFuncSetAttribute((const void*)hybrid_fwd, hipFuncAttributeMaxDynamicSharedMemorySize, LDS_BYTES) != hipSuccess) { fprintf(stderr, "kernel_launch: hipFuncSetAttribute failed\n"); grid = -1; return; }
        if (hipOccupancyMaxActiveBlocksPerMultiprocessor(&per_cu, (const void*)hybrid_fwd, NTHREADS, LDS_BYTES) != hipSuccess || per_cu < 1) { fprintf(stderr, "kernel_launch: occupancy query says %d\n", per_cu); }
        (void)hipGetLastError();
        grid = cus;
    }
    if (grid < 0) return;
    if (hipMemsetAsync((char*)d_ws + WS_CTL, 0, CTL_ZERO_BYTES, stream) != hipSuccess) { fprintf(stderr, "kernel_launch: memset failed\n"); return; }
    Args a{};
    for (int i = 0; i < 37; ++i) a.in[i] = (const float*)d_in[i];
    a.out = (float*)d_out; a.ws = (unsigned char*)d_ws;
    void* args[] = {&a};
    hipError_t e = hipLaunchCooperativeKernel((const void*)hybrid_fwd, dim3(grid), dim3(NTHREADS), args, LDS_BYTES, stream);
    if (e != hipSuccess) fprintf(stderr, "kernel_launch: cooperative launch failed: %s (grid %d)\n", hipGetErrorString(e), grid);
}
```

```cpp
#include <hip/hip_runtime.h>
#include <hip/hip_cooperative_groups.h>
#include <hip/hip_bf16.h>
#include <cstdio>
#include <cstdint>
#include <cmath>
namespace cg = cooperative_groups;
__device__ __forceinline__ int lane_asm() { int x; asm volatile("v_mbcnt_lo_u32_b32 %0, -1, 0\n\tv_mbcnt_hi_u32_b32 %0, -1, %0" : "=v"(x)); return x; }
__device__ __forceinline__ float shfl_l(float v, int srclane) { return __builtin_bit_cast(float, __builtin_amdgcn_ds_bpermute(srclane << 2, __builtin_bit_cast(int, v))); }
namespace pg8 {
#define PG8_LAS __attribute__((address_space(3)))
typedef unsigned short bf16_t;
typedef short bf16x8 __attribute__((ext_vector_type(8)));
typedef float f32x4 __attribute__((ext_vector_type(4)));
typedef unsigned u32x4 __attribute__((ext_vector_type(4)));
constexpr int BM = 256, BK = 64, HALF = 128, HTB = HALF * BK * 2  , STAGE_BYTES = 8 * HTB, NXCD = 8, WGM = 8;

__host__ __device__ __forceinline__ int lds_byte(int r, int c) { const int st = (r >> 4) * 2 + (c >> 5), rr = r & 15, cc = c & 31, ob = rr * 64 + cc * 2; return st * 1024 + (ob ^ (((ob >> 9) & 1) << 5)); }
__host__ __device__ __forceinline__ void stage_rc(int b, int& R, int& C) { const int st = b / 1024, sb = b % 1024, swz = sb ^ (((sb >> 9) & 1) << 5); R = (st >> 1) * 16 + swz / 64; C = (st & 1) * 32 + (swz % 64) / 2; }
__host__ __device__ __forceinline__ int perm32(int rho) { const int n = rho >> 4, i = rho & 15; return 8 * (i >> 2) + 4 * n + (i & 3); }

struct Unit { int pm, pn; };
struct Gemm { const bf16_t* A; int lda; const bf16_t* Bt; int M, N, K; int ov = 0; };

struct StaticOrder {
    int nM, nN, nwg, G, c, skip;
    __host__ __device__ void init(int M, int N, int G_, int c_, int skip_ = 0) { nM = skip_ ? 128 : M / BM; nN = N / BM; nwg = nM * nN; G = G_; c = c_; skip = skip_; }
    __host__ __device__ bool next(int i, Unit& u) const {
        const long L = (long)i * G + c; if (L >= nwg) return false;
        int wgid = (int)L; { const int q = nwg / NXCD, r = nwg % NXCD, xcd = wgid % NXCD, off = wgid / NXCD; wgid = (xcd < r ? xcd * (q + 1) : r * (q + 1) + (xcd - r) * q) + off; }
        const int nig = WGM * nN, gid = wgid / nig, fm = gid * WGM, gsz = (nM - fm) < WGM ? (nM - fm) : WGM;
        u.pm = fm + ((wgid % nig) % gsz); u.pn = (wgid % nig) / gsz; if (skip) u.pm += u.pm >> 5; return true;
    }
    __device__ __forceinline__ void a_ready(const Unit&) const {}
    __device__ __forceinline__ void done(const Unit&) const {}
};

__device__ __forceinline__ unsigned cvt_pk_bf16(float lo, float hi) { unsigned r; asm volatile("v_cvt_pk_bf16_f32 %0, %1, %2" : "=v"(r) : "v"(lo), "v"(hi)); return r; }
typedef float f32x2 __attribute__((ext_vector_type(2)));
__device__ __forceinline__ f32x2 gelu_pk(f32x2 v) {
    const f32x2 av = __builtin_elementwise_abs(v), d = av * 0.2316418882f + 1.0f;
    f32x2 t; t.x = __builtin_amdgcn_rcpf(d.x); t.y = __builtin_amdgcn_rcpf(d.y);
    f32x2 q = t * 0.5307027145f + (-0.7265760135f); q = q * t + 0.7107068705f; q = q * t + (-0.142248368f); q = q * t + 0.127414796f; q = q * t;
    const f32x2 s = (v * v) * (-0.72134752044f);
    f32x2 e; e.x = __builtin_amdgcn_exp2f(s.x); e.y = __builtin_amdgcn_exp2f(s.y);
    const f32x2 m = v * (q * e), r = v - m;
    f32x2 o; o.x = v.x < 0.f ? m.x : r.x; o.y = v.y < 0.f ? m.y : r.y; return o;
}

template <int ACT  > struct EpiBf16 {
    static constexpr bool PERM = true, AFTER_DRAIN = false; static_assert(ACT == 0 || ACT == 1, "EpiBf16: ACT is 0 (none) or 1 (gelu_pk)");
    bf16_t* O; int ldc; const float* bias; int split_cols; size_t split_stride; float scale0;
    __device__ __forceinline__ void operator()(const f32x4 (&acc)[2][2][4][2], const Unit& u, int wr, int wc, int fr, int fq) const {
        const int row0 = u.pm * BM + wr * 64 + fr; int colt = u.pn * BM; bf16_t* base = O;
        float sc = 1.f; if (split_cols) { const int t = colt / split_cols; base += (size_t)t * split_stride; colt -= t * split_cols; if (t == 0) sc = scale0; }
        const int col0 = colt + wc * 32 + 8 * fq, bcol0 = u.pn * BM + wc * 32 + 8 * fq;
        f32x4 bv[2][2];
#pragma unroll
        for (int bj = 0; bj < 2; ++bj)
#pragma unroll
            for (int n = 0; n < 2; ++n) bv[bj][n] = bias ? *(const f32x4*)(bias + bcol0 + bj * HALF + 4 * n) : (f32x4){0.f, 0.f, 0.f, 0.f};
#pragma unroll
        for (int ai = 0; ai < 2; ++ai)
#pragma unroll
            for (int m = 0; m < 4; ++m) { bf16_t* rowp = base + (size_t)(row0 + ai * HALF + m * 16) * ldc + col0;
#pragma unroll
                for (int bj = 0; bj < 2; ++bj) { f32x4 v0 = acc[ai][bj][m][0] + bv[bj][0], v1 = acc[ai][bj][m][1] + bv[bj][1];
                    if (ACT == 1) { f32x2 a = gelu_pk((f32x2){v0[0], v0[1]}), b = gelu_pk((f32x2){v0[2], v0[3]}), c = gelu_pk((f32x2){v1[0], v1[1]}), d = gelu_pk((f32x2){v1[2], v1[3]});
                        v0 = (f32x4){a.x, a.y, b.x, b.y}; v1 = (f32x4){c.x, c.y, d.x, d.y}; }
                    v0 = v0 * sc; v1 = v1 * sc; u32x4 w; w.x = cvt_pk_bf16(v0[0], v0[1]); w.y = cvt_pk_bf16(v0[2], v0[3]); w.z = cvt_pk_bf16(v1[0], v1[1]); w.w = cvt_pk_bf16(v1[2], v1[3]);
                    *(u32x4*)(rowp + bj * HALF) = w; } }
    }
};
template <class Epi, class Sched, bool ALIGN_EPI = false, bool SP2 = false>
__device__ __forceinline__ void gemm_phase(PG8_LAS unsigned char* lds, const Gemm g, const Sched& S, const Epi& E, int wave0) {
    int tid_ = wave0 * 64 + lane_asm(); asm volatile("" : "+v"(tid_)); const int tid = tid_, wid = __builtin_amdgcn_readfirstlane(tid >> 6), lane = tid & 63, wr = wid >> 2, wc = wid & 3, fr = lane & 15, fq = lane >> 4;
    const int K = g.K, nt = K / BK;
    unsigned voffA[2], voffB[2];
#pragma unroll
    for (int i = 0; i < 2; ++i) { int R, C; stage_rc(tid * 16 + i * 8192, R, C); const int Rb = Epi::PERM ? ((R & ~31) + perm32(R & 31)) : R;
        voffA[i] = (unsigned)((g.ov ? R - 2 * (R >> 6) : R) * g.lda + C) * 2u; voffB[i] = (unsigned)(Rb * K + C) * 2u; }
    const size_t kstep = (size_t)(BK * 2);
    const size_t hstepA = (size_t)(g.ov ? 124 : HALF) * g.lda * 2, hstepB = (size_t)HALF * K * 2;
    const size_t tstepA = 2 * hstepA, tstepB = 2 * hstepB;
    const unsigned ldsw = (unsigned)wid * 1024u;
    const int aoff = lds_byte(wr * 64 + fr, fq * 8), boff = lds_byte(wc * 32 + fr, fq * 8);
#define PG8_SA(b, h) (((b) * 2 + (h)) * HTB)
#define PG8_SB(b, h) ((4 + (b) * 2 + (h)) * HTB)
#define PG8_STAGE(bufoff, gbase, voff) do { _Pragma("unroll") for (int _i = 0; _i < 2; ++_i) \
        __builtin_amdgcn_global_load_lds((const unsigned*)((const char*)(gbase) + (voff)[_i]), (PG8_LAS unsigned*)(lds + (bufoff) + ldsw + _i * 8192), 16, 0, 0); } while (0)
#define PG8_LDA(dst, b, h) do { _Pragma("unroll") for (int m = 0; m < 4; ++m) _Pragma("unroll") for (int k = 0; k < 2; ++k) dst[m][k] = *(const PG8_LAS bf16x8*)(lds + PG8_SA(b, h) + aoff + m * 2048 + k * 1024); } while (0)
#define PG8_LDB(dst, b, h) do { _Pragma("unroll") for (int n = 0; n < 2; ++n) _Pragma("unroll") for (int k = 0; k < 2; ++k) dst[n][k] = *(const PG8_LAS bf16x8*)(lds + PG8_SB(b, h) + boff + n * 2048 + k * 1024); } while (0)
#define PG8_MMA(ai, bj, At, Bt) do { __builtin_amdgcn_s_setprio(1); _Pragma("unroll") for (int m = 0; m < 4; ++m) _Pragma("unroll") for (int n = 0; n < 2; ++n) _Pragma("unroll") for (int k = 0; k < 2; ++k) \
        acc[ai][bj][m][n] = __builtin_amdgcn_mfma_f32_16x16x32_bf16(Bt[n][k], At[m][k], acc[ai][bj][m][n], 0, 0, 0); __builtin_amdgcn_s_setprio(0); } while (0)
#define PG8_WAIT_V(n) asm volatile("s_waitcnt vmcnt(" #n ")" ::: "memory")
#define PG8_WAIT_L(n) asm volatile("s_waitcnt lgkmcnt(" #n ")" ::: "memory")
#define PG8_BAR __builtin_amdgcn_s_barrier()
#define PG8_SCHED __builtin_amdgcn_sched_barrier(0)
    Unit cur, nxt; int ui = 0;
    if (!S.next(0, cur)) return;
    f32x4 acc[2][2][4][2];
#pragma unroll
    for (int a = 0; a < 2; ++a)
#pragma unroll
        for (int b = 0; b < 2; ++b)
#pragma unroll
            for (int m = 0; m < 4; ++m)
#pragma unroll
                for (int n = 0; n < 2; ++n) acc[a][b][m][n] = (f32x4){0.f, 0.f, 0.f, 0.f};
    bf16x8 At[4][2], B0[2][2], B1[2][2];
    const char* cA = (const char*)g.A + (size_t)cur.pm * tstepA; const char* cB = (const char*)g.Bt + (size_t)cur.pn * tstepB;
    S.a_ready(cur);
    if constexpr (SP2) {
        PG8_STAGE(PG8_SB(0, 0), cB, voffB); PG8_STAGE(PG8_SB(0, 1), cB + hstepB, voffB); PG8_STAGE(PG8_SA(0, 0), cA, voffA); PG8_STAGE(PG8_SA(0, 1), cA + hstepA, voffA);
        if (wr == 1) PG8_BAR;
        PG8_WAIT_V(2); PG8_BAR;
        PG8_STAGE(PG8_SB(1, 0), cB + kstep, voffB); PG8_STAGE(PG8_SA(1, 0), cA + kstep, voffA); PG8_STAGE(PG8_SB(1, 1), cB + hstepB + kstep, voffB);
        PG8_WAIT_V(6); PG8_BAR;
    } else {
        PG8_STAGE(PG8_SB(0, 0), cB, voffB); PG8_STAGE(PG8_SA(0, 0), cA, voffA); PG8_STAGE(PG8_SB(0, 1), cB + hstepB, voffB); PG8_STAGE(PG8_SA(0, 1), cA + hstepA, voffA);
        if (wr == 1) PG8_BAR;
        PG8_WAIT_V(4); PG8_BAR;
        PG8_STAGE(PG8_SB(1, 0), cB + kstep, voffB); PG8_STAGE(PG8_SA(1, 0), cA + kstep, voffA); PG8_STAGE(PG8_SB(1, 1), cB + hstepB + kstep, voffB);
        PG8_WAIT_V(6); PG8_BAR;
    }
    for (;;) {
        const bool has_next = S.next(ui + 1, nxt);
        const char* nA = has_next ? (const char*)g.A + (size_t)nxt.pm * tstepA : cA; const char* nB = has_next ? (const char*)g.Bt + (size_t)nxt.pn * tstepB : cB;
        for (int t = 0; t < nt; t += 2) {
            const bool last = (t == nt - 2);
            const char* a1 = cA + (size_t)(t + 1) * kstep;
            const char* a2 = last ? nA : cA + (size_t)(t + 2) * kstep; const char* b2 = last ? nB : cB + (size_t)(t + 2) * kstep;
            const char* a3 = a2 + kstep; const char* b3 = b2 + kstep;
            if (last && has_next) S.a_ready(nxt);
            if constexpr (SP2) {
            PG8_LDB(B0, 0, 0); PG8_LDB(B1, 0, 1); PG8_SCHED; PG8_LDA(At, 0, 0); PG8_STAGE(PG8_SA(1, 1), a1 + hstepA, voffA);
            PG8_WAIT_V(8); PG8_WAIT_L(0); PG8_BAR; PG8_MMA(0, 0, At, B0); PG8_MMA(0, 1, At, B1); PG8_BAR; PG8_SCHED;
            PG8_LDA(At, 0, 1); PG8_STAGE(PG8_SB(0, 0), b2, voffB); PG8_STAGE(PG8_SB(0, 1), b2 + hstepB, voffB); PG8_STAGE(PG8_SA(0, 0), a2, voffA);
            PG8_WAIT_V(8); PG8_WAIT_L(0); PG8_BAR; PG8_MMA(1, 0, At, B0); PG8_MMA(1, 1, At, B1); PG8_BAR; PG8_SCHED;
            PG8_LDB(B0, 1, 0); PG8_LDB(B1, 1, 1); PG8_SCHED; PG8_LDA(At, 1, 0); PG8_STAGE(PG8_SA(0, 1), a2 + hstepA, voffA);
            PG8_WAIT_V(8); PG8_WAIT_L(0); PG8_BAR; PG8_MMA(0, 0, At, B0); PG8_MMA(0, 1, At, B1); PG8_BAR; PG8_SCHED;
            PG8_LDA(At, 1, 1); PG8_STAGE(PG8_SB(1, 0), b3, voffB); PG8_STAGE(PG8_SB(1, 1), b3 + hstepB, voffB); PG8_STAGE(PG8_SA(1, 0), a3, voffA);
            PG8_WAIT_V(8); PG8_WAIT_L(0); PG8_BAR; PG8_MMA(1, 0, At, B0); PG8_MMA(1, 1, At, B1); PG8_BAR; PG8_SCHED;
            } else {
            PG8_LDB(B0, 0, 0); PG8_SCHED; PG8_LDA(At, 0, 0); PG8_STAGE(PG8_SA(1, 1), a1 + hstepA, voffA);
            PG8_WAIT_L(8); PG8_BAR; PG8_WAIT_L(0); PG8_MMA(0, 0, At, B0); PG8_BAR; PG8_SCHED;
            PG8_LDB(B1, 0, 1); PG8_STAGE(PG8_SB(0, 0), b2, voffB);
            PG8_BAR; PG8_WAIT_L(0); PG8_MMA(0, 1, At, B1); PG8_BAR;
            PG8_LDA(At, 0, 1); PG8_STAGE(PG8_SA(0, 0), a2, voffA);
            PG8_BAR; PG8_WAIT_L(0); PG8_MMA(1, 0, At, B0); PG8_BAR; PG8_SCHED;
            PG8_STAGE(PG8_SB(0, 1), b2 + hstepB, voffB);
            PG8_WAIT_V(6); PG8_BAR; PG8_MMA(1, 1, At, B1); PG8_BAR;
            PG8_LDB(B0, 1, 0); PG8_SCHED; PG8_LDA(At, 1, 0); PG8_STAGE(PG8_SA(0, 1), a2 + hstepA, voffA);
            PG8_WAIT_L(8); PG8_BAR; PG8_WAIT_L(0); PG8_MMA(0, 0, At, B0); PG8_BAR; PG8_SCHED;
            PG8_LDB(B1, 1, 1); PG8_STAGE(PG8_SB(1, 0), b3, voffB);
            PG8_BAR; PG8_WAIT_L(0); PG8_MMA(0, 1, At, B1); PG8_BAR;
            PG8_LDA(At, 1, 1); PG8_STAGE(PG8_SA(1, 0), a3, voffA);
            PG8_BAR; PG8_WAIT_L(0); PG8_MMA(1, 0, At, B0); PG8_BAR; PG8_SCHED;
            PG8_STAGE(PG8_SB(1, 1), b3 + hstepB, voffB);
            PG8_WAIT_V(6); PG8_BAR; PG8_MMA(1, 1, At, B1); PG8_BAR;
            }
        }
        if constexpr (ALIGN_EPI) { if (wr == 0) PG8_BAR; }
        if constexpr (!Epi::AFTER_DRAIN) { E(acc, cur, wr, wc, fr, fq); S.done(cur); }
        if (!has_next) break;
#pragma unroll
        for (int a = 0; a < 2; ++a)
#pragma unroll
            for (int b = 0; b < 2; ++b)
#pragma unroll
                for (int m = 0; m < 4; ++m)
#pragma unroll
                    for (int n = 0; n < 2; ++n) acc[a][b][m][n] = (f32x4){0.f, 0.f, 0.f, 0.f};
        cur = nxt; cA = nA; cB = nB; ++ui;
        if constexpr (ALIGN_EPI) { if (wr == 1) PG8_BAR; }
    }
    PG8_WAIT_V(0);
    if constexpr (!ALIGN_EPI) { if (wr == 0) PG8_BAR; }
    PG8_BAR;
    if constexpr (Epi::AFTER_DRAIN) { E.fused(acc, cur, wr, wc, fr, fq, lds, wid, lane); S.done(cur); }
#undef PG8_SA
#undef PG8_SB
#undef PG8_STAGE
#undef PG8_LDA
#undef PG8_LDB
#undef PG8_MMA
#undef PG8_WAIT_V
#undef PG8_WAIT_L
#undef PG8_BAR
#undef PG8_SCHED
}
}
#include <hip/hip_bf16.h>
namespace attn_body {
using bf16=__hip_bfloat16;
using bf16x8=__attribute__((ext_vector_type(8)))short;
using s16x4=__attribute__((ext_vector_type(4)))short;
using f32x16=__attribute__((ext_vector_type(16)))float;
using u32x4=__attribute__((ext_vector_type(4)))unsigned;
constexpr int D=64;
constexpr int NW=8,QBLK=32,QB=QBLK*NW,KVBLK=64;
__device__ __forceinline__ int crow(int r,int hi){return (r&3)+8*(r>>2)+4*hi;}
#define SBAR() __builtin_amdgcn_sched_barrier(0)
constexpr int NSLOT=3, SLOTB=8192;
constexpr int LDS_K=0, LDS_V=NSLOT*SLOTB, LDS_WS=2*NSLOT*SLOTB, LDS_OST=LDS_WS+NW*64*4, LDS_BYTES=LDS_OST+NW*4096;
constexpr float C2=0.125f*1.4426950408889634f;
__device__ __forceinline__ void glds16(const void*gsrc,unsigned lds_dst){unsigned keep;
  asm volatile("s_mov_b32 %0, m0\n\ts_mov_b32 m0, %2\n\ts_nop 0\n\tglobal_load_lds_dwordx4 %1, off\n\ts_mov_b32 m0, %0":"=&s"(keep):"v"(gsrc),"s"(lds_dst):"memory");}
__device__ __forceinline__ float max3f(float a,float b,float c){float r;asm("v_max3_f32 %0, %1, %2, %3":"=v"(r):"v"(a),"v"(b),"v"(c));return r;}
__device__ __forceinline__ float max2f(float a,float b){float r;asm("v_max_f32_e32 %0, %1, %2":"=v"(r):"v"(a),"v"(b));return r;}
__device__ __forceinline__ float fadd_s(float a,float b){float r;asm("v_add_f32_e32 %0, %1, %2":"=v"(r):"v"(a),"v"(b));return r;}
__device__ __forceinline__ float fsub_s(float a,float b){float r;asm("v_sub_f32_e32 %0, %1, %2":"=v"(r):"v"(a),"v"(b));return r;}
typedef float f32x2_t __attribute__((ext_vector_type(2))); typedef __bf16 bf16x2_t __attribute__((ext_vector_type(2)));
__device__ __forceinline__ unsigned cvtpk_s(float lo,float hi){f32x2_t v={lo,hi};bf16x2_t b=__builtin_convertvector(v,bf16x2_t);return __builtin_bit_cast(unsigned,b);}
#define WAIT_BAR(N) asm volatile("s_waitcnt vmcnt(" #N ") lgkmcnt(0)\n\ts_barrier":::"memory")

__device__ __forceinline__ void qkt(f32x16&p0,f32x16&p1,const char*Kslot,const bf16x8*qr,const f32x16&negm,int r32,int hi){
  const char*kb=Kslot+hi*1024+r32*16;
  #pragma unroll
  for(int d0=0;d0<4;++d0){
    const bf16x8 b0=*reinterpret_cast<const bf16x8*>(kb+d0*2048);
    const bf16x8 b1=*reinterpret_cast<const bf16x8*>(kb+d0*2048+512);
    if(d0==0){p0=__builtin_amdgcn_mfma_f32_32x32x16_bf16(b0,qr[0],negm,0,0,0);p1=__builtin_amdgcn_mfma_f32_32x32x16_bf16(b1,qr[0],negm,0,0,0);}
    else{p0=__builtin_amdgcn_mfma_f32_32x32x16_bf16(b0,qr[d0],p0,0,0,0);p1=__builtin_amdgcn_mfma_f32_32x32x16_bf16(b1,qr[d0],p1,0,0,0);}}
}
typedef __attribute__((address_space(3))) const char* lds_cptr;
typedef short v4i16_t __attribute__((ext_vector_type(4)));
__device__ __forceinline__ void kload8(bf16x8*kf,lds_cptr kp){
  kf[0]=*(const __attribute__((address_space(3))) bf16x8*)(kp);      kf[1]=*(const __attribute__((address_space(3))) bf16x8*)(kp+512);
  kf[2]=*(const __attribute__((address_space(3))) bf16x8*)(kp+2048); kf[3]=*(const __attribute__((address_space(3))) bf16x8*)(kp+2560);
  kf[4]=*(const __attribute__((address_space(3))) bf16x8*)(kp+4096); kf[5]=*(const __attribute__((address_space(3))) bf16x8*)(kp+4608);
  kf[6]=*(const __attribute__((address_space(3))) bf16x8*)(kp+6144); kf[7]=*(const __attribute__((address_space(3))) bf16x8*)(kp+6656);
}
__device__ __forceinline__ void kload2(bf16x8*kf,lds_cptr kp,int j){ kf[2*j]=*(const __attribute__((address_space(3))) bf16x8*)(kp+j*2048); kf[2*j+1]=*(const __attribute__((address_space(3))) bf16x8*)(kp+j*2048+512); }
__device__ __forceinline__ s16x4 vtr(lds_cptr p){ return __builtin_bit_cast(s16x4,__builtin_amdgcn_ds_read_tr16_b64_v4i16((__attribute__((address_space(3))) v4i16_t*)p)); }
__device__ __forceinline__ float rowmax(const f32x16&p0,const f32x16&p1){
  float a=max3f(p0[0],p0[1],p1[0]),b=max3f(p0[2],p0[3],p1[1]);a=max3f(a,p1[2],p1[3]);
  #pragma unroll
  for(int r=4;r<16;r+=4){a=max3f(a,p0[r],p0[r+1]);b=max3f(b,p0[r+2],p0[r+3]);a=max3f(a,p1[r],p1[r+1]);b=max3f(b,p1[r+2],p1[r+3]);}
  const float m=max2f(a,b);
  auto rr=__builtin_amdgcn_permlane32_swap(__float_as_uint(m),__float_as_uint(m),false,false);
  return max2f(__uint_as_float(rr[0]),__uint_as_float(rr[1]));
}
__device__ __forceinline__ void pv(f32x16*o,int vb,bf16x8 pa0,bf16x8 pa1,bf16x8 pa2,bf16x8 pa3){
  #pragma unroll
  for(int d0=0;d0<2;++d0){s16x4 lo[4],hi[4];
    #pragma unroll
    for(int ks=0;ks<4;++ks){
      asm volatile("ds_read_b64_tr_b16 %0,%1 offset:%c2":"=&v"(lo[ks]):"v"(vb),"i"(d0*4096+ks*1024):"memory");
      asm volatile("ds_read_b64_tr_b16 %0,%1 offset:%c2":"=&v"(hi[ks]):"v"(vb),"i"(d0*4096+ks*1024+512):"memory");}
    asm volatile("s_waitcnt lgkmcnt(0)":::"memory");SBAR();
    #define PK(k) (bf16x8){lo[k][0],lo[k][1],lo[k][2],lo[k][3],hi[k][0],hi[k][1],hi[k][2],hi[k][3]}
    o[d0]=__builtin_amdgcn_mfma_f32_32x32x16_bf16(pa0,PK(0),o[d0],0,0,0);
    o[d0]=__builtin_amdgcn_mfma_f32_32x32x16_bf16(pa1,PK(1),o[d0],0,0,0);
    o[d0]=__builtin_amdgcn_mfma_f32_32x32x16_bf16(pa2,PK(2),o[d0],0,0,0);
    o[d0]=__builtin_amdgcn_mfma_f32_32x32x16_bf16(pa3,PK(3),o[d0],0,0,0);
    #undef PK
  }
}

#ifndef ATTN_STORE16
#define ATTN_STORE16(p,v) (*(u32x4*)(p)=(v))
#endif
template<int THRL,class TM> __device__ __forceinline__ void attn_unit(const bf16*Q,int ptq,const bf16*__restrict__ K,int ptk,const bf16*__restrict__ V,int ptv,bf16*O,int pto,int NT,const TM tm,char*shm,int wave0){
  int tid_=wave0*64+lane_asm(); asm volatile("":"+v"(tid_)); const int tid=tid_,lane=tid&63,r32=lane&31,hi=lane>>5; const int wid=__builtin_amdgcn_readfirstlane(tid>>6);
  const bf16*Qw=Q+(long)(wid*QBLK)*ptq;
  const bf16*Kh=K,*Vh=V;
  const unsigned lds0=(unsigned)(uintptr_t)shm;
  float*wsf=(float*)(shm+LDS_WS)+wid*64;
  const bf16*ksrc=Kh+(long)lane*ptk+wid*8;
  const bf16*vsrc=Vh+(long)(16*(wid&3)+(lane>>2))*ptv+(wid>>2)*32+(lane&3)*8;
  const unsigned kdst=lds0+LDS_K+wid*1024, vdst=lds0+LDS_V+wid*1024;
  #define DMA_K(t,slot) glds16(ksrc+(long)tm.row(t)*ptk,(unsigned)__builtin_amdgcn_readfirstlane(kdst+(slot)))
  #define DMA_V(t,slot) glds16(vsrc+(long)tm.row(t)*ptv,(unsigned)__builtin_amdgcn_readfirstlane(vdst+(slot)))
  const int vb0=(int)(lds0+LDS_V)+((lane>>4)&1)*32+(lane&3)*8+(4*hi+((lane&15)>>2))*64;
  const char*Kbase=shm+LDS_K; bf16x8 kf[8];
  const lds_cptr shm3=(lds_cptr)shm; const lds_cptr kp0=shm3+LDS_K+hi*1024+r32*16; const lds_cptr vp0=shm3+LDS_V+((lane>>4)&1)*32+(lane&3)*8+(4*hi+((lane&15)>>2))*64;
  DMA_K(0,0);DMA_V(0,0);DMA_K(1,SLOTB);
  bf16x8 qr[4];
  #pragma unroll
  for(int d0=0;d0<4;++d0)qr[d0]=*reinterpret_cast<const bf16x8*>(&Qw[(long)r32*ptq+d0*16+hi*8]);
  float mhat=0.f,l_reg=0.f;f32x16 o[2];o[0]=f32x16{};o[1]=f32x16{};f32x16 negm=f32x16{};asm volatile("":"+v"(negm));
  const int qrel=wid*QBLK+r32;
  #define CMASK(P0,P1,t) do{ if(TM::HAS_MASK) tm.mask(P0,P1,(t),qrel,hi); }while(0)
  bool resc=false;
  #define START(P0,P1) do{ const float rm=rowmax(P0,P1); resc=false; \
    { const float dl=rm; mhat=fadd_s(mhat,dl); \
      _Pragma("unroll") for(int r=0;r<16;++r){P0[r]=fsub_s(P0[r],dl);P1[r]=fsub_s(P1[r],dl);} \
      _Pragma("unroll") for(int r=0;r<16;++r)negm[r]=-mhat; asm volatile("":"+v"(negm)); } \
    _Pragma("unroll") for(int r=0;r<16;++r)P0[r]=__builtin_amdgcn_exp2f(P0[r]); }while(0)
  #define RESC() do{ if(resc){ asm volatile("s_waitcnt lgkmcnt(0)":::"memory"); \
      _Pragma("unroll") for(int d_=0;d_<2;++d_) _Pragma("unroll") for(int r=0;r<16;++r)o[d_][r]*=wsf[crow(r,hi)]; } }while(0)
  f32x16 pA0,pA1,pB0,pB1;
  int sl_prev=0,sl_cur=0,sl_next=SLOTB;
  #define ROT() do{sl_prev=sl_cur;sl_cur=sl_next;sl_next=(sl_next==(NSLOT-1)*SLOTB)?0:sl_next+SLOTB;}while(0)
  DMA_K(2,2*SLOTB);
  WAIT_BAR(3);
  qkt(pA0,pA1,Kbase,qr,negm,r32,hi);asm volatile("s_nop 15\n\ts_nop 7":"+v"(pA0),"+v"(pA1));
  START(pA0,pA1);
  _Pragma("unroll") for(int r=0;r<16;++r)pA1[r]=__builtin_amdgcn_exp2f(pA1[r]);
  WAIT_BAR(0);
  DMA_K(3,0);DMA_V(1,SLOTB);
  ROT();
  kload8(kf,kp0+sl_cur);
  WAIT_BAR(2);
  s16x4 vlo[8],vhi[8]; u32x4 pw0,pw1,pw2,pw3;
  #define PKW(P,B) cvtpk_s(P[B],P[B+1])
  #define PAF(k) __builtin_bit_cast(bf16x8,pw##k)
  #define VFR(i) (bf16x8){vlo[i][0],vlo[i][1],vlo[i][2],vlo[i][3],vhi[i][0],vhi[i][1],vhi[i][2],vhi[i][3]}
  #define PIN(x) asm volatile("":"+v"(x))
  #define MX3(a,b,c) __builtin_fmaxf(__builtin_fmaxf((a),(b)),(c))
  #define GAPA(MF,A0,A1,A2,A3,W0,W1,PW) do{ MF; sacc+=A0; sacc+=A1; sacc+=A2; sacc+=A3; PIN(sacc); W0; W1; PIN(PW); SBAR(); }while(0)
  #define EX(v) __builtin_amdgcn_exp2f(v)
  #define GAPB(MF,X,B) do{ MF; X[B]=EX(X[B]); X[B+1]=EX(X[B+1]); X[B+2]=EX(X[B+2]); X[B+3]=EX(X[B+3]); PIN(X); SBAR(); }while(0)
  #define VRD(i) do{ vlo[i]=vtr(vp_+(((i)>>2)*4096+((i)&3)*1024)); vhi[i]=vtr(vp_+(((i)>>2)*4096+((i)&3)*1024+512)); }while(0)
  #define KRD(G,j) do{ if(G){ kload2(kf,kp0+sl_next,j); SBAR(); } }while(0)
  #define STEP(C0,C1,P0,P1,t,GK,GV,GL) do{ SBAR(); \
    const lds_cptr vp_=vp0+sl_prev; \
    VRD(0); SBAR(); float sacc=(P0[0]+P0[1]); \
    GAPA(C0=__builtin_amdgcn_mfma_f32_32x32x16_bf16(kf[0],qr[0],negm,0,0,0), P0[2],P0[3],P0[4],P0[5],     pw0[0]=PKW(P0,0), pw0[1]=PKW(P0,2), pw0); \
    VRD(4); SBAR(); GAPA(C1=__builtin_amdgcn_mfma_f32_32x32x16_bf16(kf[1],qr[0],negm,0,0,0), P0[6],P0[7],P0[8],P0[9],     pw0[2]=PKW(P0,4), pw0[3]=PKW(P0,6), pw0); \
    VRD(1); SBAR(); GAPA(C0=__builtin_amdgcn_mfma_f32_32x32x16_bf16(kf[2],qr[1],C0,0,0,0),   P0[10],P0[11],P0[12],P0[13], pw1[0]=PKW(P0,8), pw1[1]=PKW(P0,10), pw1); \
    VRD(5); SBAR(); GAPA(C1=__builtin_amdgcn_mfma_f32_32x32x16_bf16(kf[3],qr[1],C1,0,0,0),   P0[14],P0[15],P1[0],P1[1],   pw1[2]=PKW(P0,12),pw1[3]=PKW(P0,14), pw1); \
    VRD(2); SBAR(); GAPA(C0=__builtin_amdgcn_mfma_f32_32x32x16_bf16(kf[4],qr[2],C0,0,0,0),   P1[2],P1[3],P1[4],P1[5],     pw2[0]=PKW(P1,0), pw2[1]=PKW(P1,2), pw2); \
    VRD(6); SBAR(); GAPA(C1=__builtin_amdgcn_mfma_f32_32x32x16_bf16(kf[5],qr[2],C1,0,0,0),   P1[6],P1[7],P1[8],P1[9],     pw2[2]=PKW(P1,4), pw2[3]=PKW(P1,6), pw2); \
    VRD(3); SBAR(); GAPA(C0=__builtin_amdgcn_mfma_f32_32x32x16_bf16(kf[6],qr[3],C0,0,0,0),   P1[10],P1[11],P1[12],P1[13], pw3[0]=PKW(P1,8), pw3[1]=PKW(P1,10), pw3); \
    VRD(7); SBAR(); GAPA(C1=__builtin_amdgcn_mfma_f32_32x32x16_bf16(kf[7],qr[3],C1,0,0,0),   P1[14],P1[15],0.f,0.f,       pw3[2]=PKW(P1,12),pw3[3]=PKW(P1,14), pw3); \
    l_reg+=sacc; \
    if(GK){DMA_K((t)+3,sl_cur);} if(GV){DMA_V((t)+1,sl_next);} \
    CMASK(C0,C1,t); \
    { float a=MX3(C0[0],C0[1],C1[0]),b=MX3(C0[2],C0[3],C1[1]); a=MX3(a,C1[2],C1[3]); \
      _Pragma("unroll") for(int r=4;r<16;r+=4){a=MX3(a,C0[r],C0[r+1]);b=MX3(b,C0[r+2],C0[r+3]);a=MX3(a,C1[r],C1[r+1]);b=MX3(b,C1[r+2],C1[r+3]);} \
      float rm=__builtin_fmaxf(a,b); { auto rr=__builtin_amdgcn_permlane32_swap(__float_as_uint(rm),__float_as_uint(rm),false,false); rm=__builtin_fmaxf(__uint_as_float(rr[0]),__uint_as_float(rr[1])); } \
      resc=false; \
      if(__builtin_expect(__any(rm>(float)THRL),0)){ const float dl=__builtin_fmaxf(rm,0.f); mhat+=dl; \
        _Pragma("unroll") for(int r=0;r<16;++r){C0[r]-=dl;C1[r]-=dl;} \
        _Pragma("unroll") for(int r=0;r<16;++r)negm[r]=-mhat; asm volatile("":"+v"(negm)); \
        const float f=__builtin_amdgcn_exp2f(-dl); l_reg*=f; if(hi==0)wsf[r32]=f; resc=true; } } \
    SBAR(); \
    GAPB(o[0]=__builtin_amdgcn_mfma_f32_32x32x16_bf16(PAF(0),VFR(0),o[0],0,0,0), C0,0); \
    GAPB(o[1]=__builtin_amdgcn_mfma_f32_32x32x16_bf16(PAF(0),VFR(4),o[1],0,0,0), C0,4); \
    KRD(GL,0); GAPB(o[0]=__builtin_amdgcn_mfma_f32_32x32x16_bf16(PAF(1),VFR(1),o[0],0,0,0), C0,8); \
    KRD(GL,1); GAPB(o[1]=__builtin_amdgcn_mfma_f32_32x32x16_bf16(PAF(1),VFR(5),o[1],0,0,0), C0,12); \
    KRD(GL,2); GAPB(o[0]=__builtin_amdgcn_mfma_f32_32x32x16_bf16(PAF(2),VFR(2),o[0],0,0,0), C1,0); \
    KRD(GL,3); GAPB(o[1]=__builtin_amdgcn_mfma_f32_32x32x16_bf16(PAF(2),VFR(6),o[1],0,0,0), C1,4); \
    GAPB(o[0]=__builtin_amdgcn_mfma_f32_32x32x16_bf16(PAF(3),VFR(3),o[0],0,0,0), C1,8); \
    GAPB(o[1]=__builtin_amdgcn_mfma_f32_32x32x16_bf16(PAF(3),VFR(7),o[1],0,0,0), C1,12); \
    }while(0)
  int t=1;
  for(;t+5<NT;t+=2){
    STEP(pB0,pB1,pA0,pA1,t,true,true,true);     WAIT_BAR(2); RESC(); ROT();
    STEP(pA0,pA1,pB0,pB1,t+1,true,true,true);   WAIT_BAR(2); RESC(); ROT();
  }
  #define ENDW(tt) do{ if((tt)+3<NT){WAIT_BAR(2);} else if((tt)+2<NT){WAIT_BAR(1);} else {WAIT_BAR(0);} }while(0)
  for(;t+1<NT;t+=2){
    STEP(pB0,pB1,pA0,pA1,t,(t+3<NT),(t+1<NT),(t+1<NT));       ENDW(t);   RESC(); ROT();
    STEP(pA0,pA1,pB0,pB1,t+1,(t+4<NT),(t+2<NT),(t+2<NT));     ENDW(t+1); RESC(); ROT();
  }
  STEP(pB0,pB1,pA0,pA1,NT-1,false,false,false); RESC();
  { float sacc=pB0[0]+pB0[1]; _Pragma("unroll") for(int r=2;r<16;++r)sacc+=pB0[r]; _Pragma("unroll") for(int r=0;r<16;++r)sacc+=pB1[r]; l_reg+=sacc;
    pw0=(u32x4){PKW(pB0,0),PKW(pB0,2),PKW(pB0,4),PKW(pB0,6)};pw1=(u32x4){PKW(pB0,8),PKW(pB0,10),PKW(pB0,12),PKW(pB0,14)};pw2=(u32x4){PKW(pB1,0),PKW(pB1,2),PKW(pB1,4),PKW(pB1,6)};pw3=(u32x4){PKW(pB1,8),PKW(pB1,10),PKW(pB1,12),PKW(pB1,14)};
    SBAR(); pv(o,vb0+sl_cur,PAF(0),PAF(1),PAF(2),PAF(3)); }
  #undef PKW
  #undef PAF
  #undef VFR
  #undef PIN
  #undef MX3
  #undef GAPA
  #undef GAPB
  #undef EX
  #undef VRD
  #undef KRD
  #undef STEP
  #undef ENDW
  {auto rr=__builtin_amdgcn_permlane32_swap(__float_as_uint(l_reg),__float_as_uint(l_reg),false,false);l_reg=__uint_as_float(rr[0])+__uint_as_float(rr[1]);}
  if(hi==0)wsf[32+r32]=l_reg;asm volatile("s_waitcnt lgkmcnt(0)":::"memory");
  float rli[16];
  #pragma unroll
  for(int r=0;r<16;++r)rli[r]=__builtin_amdgcn_rcpf(wsf[32+crow(r,hi)]);
  bf16*Ow=O+(long)(wid*QBLK)*pto;
  { bf16*stg=(bf16*)(shm+LDS_OST)+wid*2048;
    #pragma unroll
    for(int r=0;r<16;++r){const int orow=crow(r,hi);
      #pragma unroll
      for(int d0=0;d0<2;++d0)stg[orow*64+d0*32+r32]=__float2bfloat16(o[d0][r]*rli[r]);}
    asm volatile("s_waitcnt lgkmcnt(0)":::"memory");
    #pragma unroll
    for(int i=0;i<4;++i){const int row=i*8+(lane>>3),ch=lane&7; const u32x4 v=*(const u32x4*)(stg+row*64+ch*8); ATTN_STORE16(Ow+(long)row*pto+ch*8,v);} }
  asm volatile("s_waitcnt lgkmcnt(0)\n\ts_barrier":::"memory");
  #undef DMA_K
  #undef DMA_V
  #undef CMASK
  #undef START
  #undef RESC
  #undef ROT
}
constexpr int ATTN_LDS_BYTES=LDS_BYTES;
#undef SBAR
#undef WAIT_BAR
}
#define GAS __attribute__((address_space(1)))
#define LAS __attribute__((address_space(3)))
typedef unsigned short bf16;
typedef unsigned v4u __attribute__((ext_vector_type(4)));
typedef unsigned v2u __attribute__((ext_vector_type(2)));
typedef float f32x4 __attribute__((ext_vector_type(4)));
typedef float f32x16 __attribute__((ext_vector_type(16)));
typedef short bf16x8 __attribute__((ext_vector_type(8)));

constexpr int DMODEL = 1024, NBATCH = 4, SEQ = 8192, CTXL = 256, TPB = SEQ + CTXL, MROWS = NBATCH * TPB;
constexpr int FFH = 2816, NUP = 2 * FFH, NIN_E = 3072, NIN_O = 2304;
constexpr float EPS = 1e-6f;
constexpr float QSCALE = 0.125f * 1.4426950408889634f;
constexpr int NWAVES = 8, NTHREADS = 512;
constexpr int RING_BYTES = 131072, MISC_OFF = 139264, LDS_BYTES = 147456;

constexpr size_t MiB = (size_t)1 << 20;
constexpr size_t WS_CTL = 0, CTL_ZERO_BYTES = 64 * 1024;
constexpr size_t WS_MODS = 1 * MiB, WS_ROPE = 2 * MiB, WS_H3L = 4 * MiB, WS_H3C = 8 * MiB, WS_PART = 9 * MiB;
constexpr size_t WS_W = 10 * MiB, WS_WIN = WS_W, WS_WOUT = WS_W + 6 * MiB, WS_WUP = WS_W + 8 * MiB, WS_WDOWN = WS_W + 19 * MiB;
constexpr size_t WS_XC = 36 * MiB, WS_FILT = 40 * MiB, WS_FILTC = 72 * MiB, WS_YTC = 73 * MiB;
constexpr size_t WS_H = 74 * MiB, WS_U = 140 * MiB, WS_ZT = 338 * MiB, WS_X0T = 370 * MiB, WS_DAO = 338 * MiB, WS_GV = 140 * MiB;
constexpr size_t WS_END = 512 * MiB;
static_assert(WS_GV + (size_t)MROWS * NUP * 2 <= WS_END && WS_U + (size_t)MROWS * NIN_E * 2 <= WS_ZT && WS_DAO + (size_t)MROWS * 1024 * 2 <= WS_END, "ws map");
constexpr int CW_QUEUE = 1024;
constexpr int CW_BAR = 8192;

struct Args { const float* in[37]; float* out; unsigned char* ws; };
enum { I_X = 0, I_C, I_CTX, I_CCTX, I_WADA, I_BADA, I_WUP, I_FCW, I_FCB, I_WDOWN, I_WINE, I_WOUTE, I_NAQG, I_NAKG, I_RPB, I_DAQG, I_DAKG, I_LQ1, I_LK1, I_LQ2, I_LK2, I_SUBLN,
       I_WINO, I_WOUTO, I_GQG, I_GKG, I_HCW, I_HCB, I_HW1, I_HB1, I_HW2, I_HB2, I_HW3, I_HB3, I_HW4, I_HFREQ, I_HSKIP };

struct Frame { LAS unsigned char* lds; int tid, lane, wave, G, bid, wave0; };

__device__ __forceinline__ unsigned f2bf(float f) { unsigned u = __builtin_bit_cast(unsigned, f); return (u + 0x7fffu + ((u >> 16) & 1u)) >> 16; }
__device__ __forceinline__ unsigned pk2(float lo, float hi) { return f2bf(lo) | (f2bf(hi) << 16); }
__device__ __forceinline__ float bf2f(unsigned short h) { return __builtin_bit_cast(float, (unsigned)h << 16); }
__device__ __forceinline__ float bflo(unsigned w) { return __builtin_bit_cast(float, w << 16); }
__device__ __forceinline__ float bfhi(unsigned w) { return __builtin_bit_cast(float, w & 0xffff0000u); }
__device__ __forceinline__ float wave_sum(float v, int lane) {
#pragma unroll
    for (int o = 1; o < 64; o <<= 1) v += shfl_l(v, lane ^ o);
    return v;
}
#define LDS_WAIT() asm volatile("s_waitcnt lgkmcnt(0)" ::: "memory")

__device__ __forceinline__ const float* xrow_c(const float* xl, const float* xc, int row) { const int b = row / TPB, t = row - b * TPB; return t < SEQ ? xl + ((size_t)b * SEQ + t) * DMODEL : xc + ((size_t)b * CTXL + (t - SEQ)) * DMODEL; }
__device__ __forceinline__ float* xrow_m(float* xl, float* xc, int row) { const int b = row / TPB, t = row - b * TPB; return t < SEQ ? xl + ((size_t)b * SEQ + t) * DMODEL : xc + ((size_t)b * CTXL + (t - SEQ)) * DMODEL; }
__device__ __forceinline__ int modrow(int row) { const int b = row / TPB, t = row - b * TPB; return t < SEQ ? b : 4; }

struct EpiStore {
    static constexpr bool PERM = true, AFTER_DRAIN = false;
    bf16* O; int ldc;
    __device__ __forceinline__ void operator()(const pg8::f32x4 (&acc)[2][2][4][2], const pg8::Unit& u, int wr, int wc, int fr, int fq) const {
        const int row0 = u.pm * 256 + wr * 64 + fr, col0 = u.pn * 256 + wc * 32 + 8 * fq;
#pragma unroll
        for (int ai = 0; ai < 2; ++ai)
#pragma unroll
            for (int m = 0; m < 4; ++m) { bf16* rowp = O + (size_t)(row0 + ai * 128 + m * 16) * ldc + col0;
#pragma unroll
                for (int bj = 0; bj < 2; ++bj) { const pg8::f32x4 v0 = acc[ai][bj][m][0], v1 = acc[ai][bj][m][1];
                    v4u w; w.x = pg8::cvt_pk_bf16(v0[0], v0[1]); w.y = pg8::cvt_pk_bf16(v0[2], v0[3]); w.z = pg8::cvt_pk_bf16(v1[0], v1[1]); w.w = pg8::cvt_pk_bf16(v1[2], v1[3]);
                    *(v4u*)(rowp + bj * 128) = w; } }
    }
};
struct EpiResid {
    static constexpr bool PERM = false, AFTER_DRAIN = false;
    const float* sl; const float* sc; float* dl; float* dc; const float* gate; float mul = 1.f;
    __device__ __forceinline__ void operator()(const pg8::f32x4 (&acc)[2][2][4][2], const pg8::Unit& u, int wr, int wc, int fr, int fq) const {
        const int col0 = u.pn * 256 + wc * 32 + 4 * fq;
        const int r0 = u.pm * 256, b = r0 / TPB, t0 = r0 - b * TPB; const bool lat = t0 < SEQ;
        const float* sp0 = (lat ? sl + ((size_t)b * SEQ + t0) * DMODEL : sc + ((size_t)b * CTXL + (t0 - SEQ)) * DMODEL) + col0;
        float* dp0 = (lat ? dl + ((size_t)b * SEQ + t0) * DMODEL : dc + ((size_t)b * CTXL + (t0 - SEQ)) * DMODEL) + col0;
        const float* gp = gate + (size_t)(lat ? b : 4) * 6144 + col0;
        f32x4 gv[2][2];
#pragma unroll
        for (int bj = 0; bj < 2; ++bj)
#pragma unroll
            for (int n = 0; n < 2; ++n) gv[bj][n] = *(const f32x4*)(gp + bj * 128 + n * 16) * mul;
#pragma unroll
        for (int am = 0; am < 4; ++am) {
            const int ai = am >> 1, m0 = (am & 1) * 2;
            f32x4 xv[2][2][2];
#pragma unroll
            for (int mm = 0; mm < 2; ++mm) { const float* sp = sp0 + (size_t)(ai * 128 + wr * 64 + (m0 + mm) * 16 + fr) * DMODEL;
#pragma unroll
                for (int bj = 0; bj < 2; ++bj)
#pragma unroll
                    for (int n = 0; n < 2; ++n) xv[mm][bj][n] = *(const f32x4*)(sp + bj * 128 + n * 16); }
            asm volatile("" ::: "memory");
#pragma unroll
            for (int mm = 0; mm < 2; ++mm) { float* dp = dp0 + (size_t)(ai * 128 + wr * 64 + (m0 + mm) * 16 + fr) * DMODEL;
#pragma unroll
                for (int bj = 0; bj < 2; ++bj)
#pragma unroll
                    for (int n = 0; n < 2; ++n) { const f32x4 x = xv[mm][bj][n], g = gv[bj][n];
                        const pg8::f32x4 a = acc[ai][bj][m0 + mm][n]; f32x4 o; o.x = x.x + g.x * a[0]; o.y = x.y + g.y * a[1]; o.z = x.z + g.z * a[2]; o.w = x.w + g.w * a[3];
                        *(f32x4*)(dp + bj * 128 + n * 16) = o; } }
            asm volatile("" ::: "memory");
        }
    }
};

struct EpiConv {
    static constexpr bool PERM = true, AFTER_DRAIN = false;
    bf16* ACT; const float* cw; const float* cb;
    __device__ __forceinline__ void operator()(const pg8::f32x4 (&acc)[2][2][4][2], const pg8::Unit& u, int wr, int wc, int fr, int fq) const {
        const int j0 = u.pn * 128 + wc * 32 + 8 * fq;
        float w0[8], w1[8], w2[8], bb[8];
#pragma unroll
        for (int e = 0; e < 8; ++e) { w0[e] = cw[j0 + e]; w1[e] = cw[FFH + j0 + e]; w2[e] = cw[2 * FFH + j0 + e]; bb[e] = cb[j0 + e]; }
#pragma unroll
        for (int ai = 0; ai < 2; ++ai) {
            const int blk0 = u.pm * 248 + 62 * (2 * ai + wr) - 1;
#pragma unroll
            for (int m = 0; m < 4; ++m) {
                const int rho = 16 * m + fr, gr = blk0 + rho; const int ts = gr % TPB;
                const bool zp = (ts == 0) || (ts == SEQ), zn = (ts == SEQ - 1) || (ts == TPB - 1);
                unsigned ow[4];
#pragma unroll
                for (int n = 0; n < 2; ++n)
#pragma unroll
                    for (int e = 0; e < 4; e += 2) { float r2[2];
#pragma unroll
                        for (int q = 0; q < 2; ++q) { const int ee = e + q, ce = 4 * n + ee;
                            const float g = acc[ai][0][m][n][ee], v = acc[ai][1][m][n][ee];
                            const float gm1 = acc[ai][0][m > 0 ? m - 1 : 0][n][ee], gp1 = acc[ai][0][m < 3 ? m + 1 : 3][n][ee];
                            const float pa = __builtin_bit_cast(float, __builtin_amdgcn_update_dpp(0, __builtin_bit_cast(int, fr == 15 ? gm1 : g), 0x121, 0xf, 0xf, false));
                            const float na = __builtin_bit_cast(float, __builtin_amdgcn_update_dpp(0, __builtin_bit_cast(int, fr == 0 ? gp1 : g), 0x12F, 0xf, 0xf, false));
                            const float prev = zp ? 0.f : pa, next = zn ? 0.f : na;
                            const float t = w0[ce] * prev + w1[ce] * g + w2[ce] * next + bb[ce];
                            r2[q] = t * __builtin_amdgcn_rcpf(1.f + __expf(-t)) * v; }
                        ow[2 * n + (e >> 1)] = pg8::cvt_pk_bf16(r2[0], r2[1]); }
                if (rho >= 1 && rho <= 62 && gr < MROWS) *(v4u*)(ACT + (size_t)gr * FFH + j0) = (v4u){ow[0], ow[1], ow[2], ow[3]};
            }
        }
    }
};

__device__ __forceinline__ void ctx_strip_gemm(const Frame& F0, const bf16* A, int lda, const bf16* Wt, int K, const float* xc_src, float* xc_dst, const float* gate_ctx, int ncb = 16, bf16* outb = nullptr, int ldo = 0) {
    int tid = F0.wave0 * 64 + lane_asm(); asm volatile("" : "+v"(tid));
    const int lane = tid & 63, wave = __builtin_amdgcn_readfirstlane(tid >> 6), fr = lane & 15, fq = lane >> 4;
    LAS f32x4* red = (LAS f32x4*)F0.lds;
    const int kc = K >> 3;
    for (int it = F0.bid; it < 16 * ncb; it += F0.G) {
        const int rs = it / ncb, cb = it - rs * ncb;
        const bf16* ap[4]; const bf16* bp[4];
#pragma unroll
        for (int g = 0; g < 4; ++g) { const int cr = rs * 64 + g * 16 + fr, b = cr >> 8, t = cr & 255;
            ap[g] = A + ((size_t)b * TPB + SEQ + t) * lda + wave * kc + 8 * fq; bp[g] = Wt + (size_t)(cb * 64 + g * 16 + fr) * K + wave * kc + 8 * fq; }
        f32x4 acc[4][4];
#pragma unroll
        for (int rg = 0; rg < 4; ++rg)
#pragma unroll
            for (int cg = 0; cg < 4; ++cg) acc[rg][cg] = (f32x4){0.f, 0.f, 0.f, 0.f};
#pragma unroll 2
        for (int k0 = 0; k0 < kc; k0 += 32) {
            bf16x8 av[4], bv[4];
#pragma unroll
            for (int g = 0; g < 4; ++g) { av[g] = *(const bf16x8*)(ap[g] + k0); bv[g] = *(const bf16x8*)(bp[g] + k0); }
#pragma unroll
            for (int rg = 0; rg < 4; ++rg)
#pragma unroll
                for (int cg = 0; cg < 4; ++cg) acc[rg][cg] = __builtin_amdgcn_mfma_f32_16x16x32_bf16(bv[cg], av[rg], acc[rg][cg], 0, 0, 0);
        }
#pragma unroll
        for (int rg = 0; rg < 4; ++rg)
#pragma unroll
            for (int cg = 0; cg < 4; ++cg) red[(wave * 16 + rg * 4 + cg) * 64 + lane] = acc[rg][cg];
        __syncthreads();
#pragma unroll
        for (int h = 0; h < 2; ++h) { const int o = tid + 512 * h, tile = o >> 6, ln = o & 63, rg = tile >> 2, cg = tile & 3, ofr = ln & 15, ofq = ln >> 4;
            f32x4 s = red[o];
#pragma unroll
            for (int w = 1; w < 8; ++w) s += red[w * 1024 + o];
            const int cr = rs * 64 + rg * 16 + ofr, b = cr >> 8, t = cr & 255, col = cb * 64 + cg * 16 + 4 * ofq;
            if (outb) { v2u o; o.x = pk2(s.x, s.y); o.y = pk2(s.z, s.w); *(v2u*)(outb + ((size_t)b * TPB + SEQ + t) * ldo + col) = o; }
            else { const size_t xo = ((size_t)b * CTXL + t) * DMODEL + col;
                const f32x4 x0 = *(const f32x4*)(xc_src + xo), g0 = *(const f32x4*)(gate_ctx + col);
                *(f32x4*)(xc_dst + xo) = x0 + g0 * s; } }
        __syncthreads();
    }
}

__device__ __forceinline__ void transpose_item(const float* W, int K, int N, bf16* WT, LAS float* scr, int item, int lane, bool upmap = false) {
    const int nblk = N / 32, kb = item / nblk, nb = item % nblk, k0 = 64 * kb, n0 = 32 * nb;
    float wv[32];
#pragma unroll
    for (int i = 0; i < 32; ++i) wv[i] = W[(size_t)(k0 + 2 * i + (lane >> 5)) * N + n0 + (lane & 31)];
#pragma unroll
    for (int i = 0; i < 32; ++i) { const int kk = 2 * i + (lane >> 5); scr[kk * 33 + (lane & 31)] = wv[i]; }
    LDS_WAIT();
    const int c = lane & 7;
#pragma unroll
    for (int j = 0; j < 4; ++j) { const int n = (lane >> 3) + 8 * j; const LAS float* s = scr + (8 * c) * 33 + n;
        v4u o; o.x = pk2(s[0 * 33], s[1 * 33]); o.y = pk2(s[2 * 33], s[3 * 33]); o.z = pk2(s[4 * 33], s[5 * 33]); o.w = pk2(s[6 * 33], s[7 * 33]);
        const int nn = n0 + n, drow = !upmap ? nn : (nn < FFH ? 256 * (nn >> 7) + (nn & 127) : 256 * ((nn - FFH) >> 7) + 128 + ((nn - FFH) & 127));
        *(v4u*)(WT + (size_t)drow * K + k0 + 8 * c) = o; }
    LDS_WAIT();
}
typedef unsigned v4u_unused_;
#define RLX_AGENT __ATOMIC_RELAXED, __HIP_MEMORY_SCOPE_AGENT
#define XB_TMO      128
#define XB_XCNT(j)  (256  + 64 * (j))
#define XB_XSUB(j)  (1280 + 64 * (j))
#define XB_XGEN(j)  (2304 + 64 * (j))
#define XB_TOP      3328
#define XB_TOPGEN   3392
#define XCD_BAR_WORDS 3456
#define XB_SPIN_CAP (1u << 18)

__device__ __forceinline__ unsigned xb_ld(unsigned* p)              { return __hip_atomic_load(p, __ATOMIC_RELAXED, __HIP_MEMORY_SCOPE_AGENT); }
__device__ __forceinline__ unsigned xb_add(unsigned* p, unsigned v) { return __hip_atomic_fetch_add(p, v, __ATOMIC_RELAXED, __HIP_MEMORY_SCOPE_AGENT); }
__device__ __forceinline__ unsigned xb_xcc_id() { return (unsigned)__builtin_amdgcn_s_getreg((3 << 11) | 20) & 0xFu; }
#define XB_SPIN(cond, bar) do { unsigned _sp = 0; while (cond) { __builtin_amdgcn_s_sleep(1); \
    if ((++_sp & 255u) == 0u) { if (xb_ld(&(bar)[XB_TMO])) break; if (_sp > XB_SPIN_CAP) { atomicAdd(&(bar)[XB_TMO], 1u); break; } } } } while (0)

struct XcdBarrier {
    unsigned* bar; unsigned x;
    volatile LAS unsigned* st;
};

__device__ __forceinline__ XcdBarrier xcd_barrier_post(unsigned* bar, volatile LAS unsigned* st) {
    XcdBarrier b; b.bar = bar; b.x = xb_xcc_id(); b.st = st;
    if (threadIdx.x == 0) (void)xb_add(&bar[XB_XCNT(b.x)], 1u);
    return b;
}
__device__ __forceinline__ void xcd_barrier_complete(unsigned* bar, unsigned x, unsigned& nloc, unsigned& nx) {
    asm volatile("" : "+s"(bar));
    asm volatile("" : "+s"(x));
    const unsigned G = gridDim.x * gridDim.y * gridDim.z;
    unsigned sum, cnt, mine, sp = 0u;
    for (;;) {
        sum = 0u; cnt = 0u; mine = 0u;
#pragma unroll
        for (unsigned j = 0; j < 16; ++j) { const unsigned c = xb_ld(&bar[XB_XCNT(j)]); sum += c; cnt += (c > 0u) ? 1u : 0u; mine = (j == x) ? c : mine; }
        if (sum == G) break;
        __builtin_amdgcn_s_sleep(1);
        if ((++sp & 255u) == 0u) { if (xb_ld(&bar[XB_TMO])) break; if (sp > XB_SPIN_CAP) { atomicAdd(&bar[XB_TMO], 1u); break; } }
    }
    nloc = mine > 0u ? mine : 1u; nx = cnt > 0u ? cnt : 1u;
}

__device__ __forceinline__ void xcd_barrier(const XcdBarrier& b) {
    asm volatile("s_waitcnt vmcnt(0)" ::: "memory");
    __syncthreads();
    if (threadIdx.x == 0) {
        unsigned* bar = b.bar; asm volatile("" : "+s"(bar));
        __builtin_amdgcn_s_waitcnt(0);
        unsigned nloc = b.st[0], nx = b.st[1];
        if (nloc == 0u) { xcd_barrier_complete(bar, b.x, nloc, nx); b.st[0] = nloc; b.st[1] = nx; }
        const unsigned old = xb_add(&bar[XB_XSUB(b.x)], 1u);
        const unsigned gen = old / nloc;
        if (old + 1u == (gen + 1u) * nloc) {
            __builtin_amdgcn_fence(__ATOMIC_RELEASE, "agent");
            asm volatile("s_waitcnt vmcnt(0)" ::: "memory");
            const unsigned og = xb_add(&bar[XB_TOP], 1u);
            const unsigned tg = og / nx;
            if (og + 1u == (tg + 1u) * nx) xb_add(&bar[XB_TOPGEN], 1u);
            else XB_SPIN(xb_ld(&bar[XB_TOPGEN]) == tg, bar);
            __builtin_amdgcn_fence(__ATOMIC_ACQUIRE, "agent");
            xb_add(&bar[XB_XGEN(b.x)], 1u);
            asm volatile("s_waitcnt vmcnt(0)" ::: "memory");
        } else {
            XB_SPIN(xb_ld(&bar[XB_XGEN(b.x)]) == gen, bar);
            __builtin_amdgcn_fence(__ATOMIC_ACQUIRE, "agent");
            asm volatile("s_waitcnt vmcnt(0)" ::: "memory");
        }
    }
    __syncthreads();
}
__device__ __forceinline__ void p0_prologue(Frame& F0, const Args& a) {
    Frame F = F0; { int t_ = F0.wave0 * 64 + lane_asm(); asm volatile("" : "+v"(t_)); F.tid = t_; F.lane = t_ & 63; F.wave = __builtin_amdgcn_readfirstlane(t_ >> 6); } int lz = 0; asm volatile("" : "+s"(lz)); unsigned char* wsl = (unsigned char*)((unsigned long long)a.ws ^ (unsigned long long)(unsigned)lz);
    unsigned char* ws = wsl;
    float* MODS = (float*)(ws + WS_MODS);
    LAS float* sC = (LAS float*)F.lds;
    LAS float* red = sC + 5 * 1024;
    for (int i = F.tid; i < 5 * 1024; i += NTHREADS) { const float v = i < 4096 ? a.in[lz + I_C][i] : a.in[lz + I_CCTX][i - 4096]; sC[i] = v / (1.f + expf(-v)); }
    __syncthreads();
    for (int it = F.bid; it < 384; it += F.G) {
        const int l = it / 96, n0 = (it % 96) * 64, n = n0 + F.lane;
        const float* W = a.in[lz + I_WADA] + (size_t)l * 1024 * 6144 + n;
        float a0 = 0.f, a1 = 0.f, a2 = 0.f, a3 = 0.f, a4 = 0.f;
        const int k0 = F.wave * 128;
#pragma unroll 16
        for (int k = k0; k < k0 + 128; ++k) { const float w = W[(size_t)k * 6144];
            a0 += sC[k] * w; a1 += sC[1024 + k] * w; a2 += sC[2048 + k] * w; a3 += sC[3072 + k] * w; a4 += sC[4096 + k] * w; }
        red[(F.wave * 5 + 0) * 64 + F.lane] = a0; red[(F.wave * 5 + 1) * 64 + F.lane] = a1; red[(F.wave * 5 + 2) * 64 + F.lane] = a2;
        red[(F.wave * 5 + 3) * 64 + F.lane] = a3; red[(F.wave * 5 + 4) * 64 + F.lane] = a4;
        __syncthreads();
        if (F.tid < 320) { const int r = F.tid >> 6, ln = F.tid & 63; float s = 0.f;
#pragma unroll
            for (int w = 0; w < 8; ++w) s += red[(w * 5 + r) * 64 + ln];
            MODS[((size_t)l * 5 + r) * 6144 + n0 + ln] = s + a.in[lz + I_BADA][l * 6144 + n0 + ln]; }
        __syncthreads();
    }
    float* ROPE = (float*)(ws + WS_ROPE);
    for (int idx = F.bid * NTHREADS + F.tid; idx < SEQ * 32; idx += F.G * NTHREADS) {
        const int t = idx >> 5, pi = idx & 31, pos = pi < 16 ? (t >> 6) : (t & 63), m = pi & 15;
        const float inv = powf(10000.f, -(float)m / 16.f), ang = (float)pos * inv;
        ROPE[2 * idx] = cosf(ang); ROPE[2 * idx + 1] = sinf(ang);
    }
    float* H3L = (float*)(ws + WS_H3L); float* H3C = (float*)(ws + WS_H3C);
    for (int item = F.bid * NWAVES + F.wave; item < 2 * 8448; item += F.G * NWAVES) {
        const int i = item / 8448, rem = item % 8448, type = rem >= 8192 ? 1 : 0, p = type ? rem - 8192 : rem, L = type ? 256 : 8192;
        const int e = F.lane;
        const float tt = (float)p / (float)(L - 1);
        const float w = 6.283185307179586f * (float)p / (float)L;
        float zv = 0.f;
        if (e == 0) zv = tt;
        else if (e <= 32) { const int m = (e - 1) & 15; const float f = 1e-4f + (float)m * ((15.f - 1e-4f) / 15.f); const float ar = f * w; zv = e <= 16 ? cosf(ar) : -sinf(ar); }
        const float fr = a.in[lz + I_HFREQ][i * 64 + e];
        float acc = a.in[lz + I_HB1][i * 64 + e];
#pragma unroll 11
        for (int k = 0; k < 33; ++k) acc += shfl_l(zv, k) * a.in[lz + I_HW1][(i * 33 + k) * 64 + e];
        float h = sinf(fr * acc);
        acc = a.in[lz + I_HB2][i * 64 + e];
#pragma unroll 16
        for (int k = 0; k < 64; ++k) acc += shfl_l(h, k) * a.in[lz + I_HW2][(i * 64 + k) * 64 + e];
        h = sinf(fr * acc);
        acc = a.in[lz + I_HB3][i * 64 + e];
#pragma unroll 16
        for (int k = 0; k < 64; ++k) acc += shfl_l(h, k) * a.in[lz + I_HW3][(i * 64 + k) * 64 + e];
        h = sinf(fr * acc);
        if (type) H3C[((size_t)i * 256 + p) * 64 + e] = h; else H3L[((size_t)i * 8192 + p) * 64 + e] = h;
    }
}

__device__ __forceinline__ void norm_phase(Frame& F0, const float* xl, const float* xc, const float* mods_l, int shoff, bf16* H) {
    Frame F = F0; { int t_ = F0.wave0 * 64 + lane_asm(); asm volatile("" : "+v"(t_)); F.tid = t_; F.lane = t_ & 63; F.wave = __builtin_amdgcn_readfirstlane(t_ >> 6); } int lz = 0; asm volatile("" : "+s"(lz));
    const int gw = F.bid * NWAVES + F.wave, NGW = F.G * NWAVES;
    for (int row = gw; row < MROWS; row += 3 * NGW) {
        int rw[3]; bool ok[3]; const f32x4* xr[3]; f32x4 v[3][4];
#pragma unroll
        for (int q = 0; q < 3; ++q) { rw[q] = row + q * NGW; ok[q] = rw[q] < MROWS; if (!ok[q]) rw[q] = row; xr[q] = (const f32x4*)xrow_c(xl, xc, rw[q]) + F.lane;
#pragma unroll
            for (int j = 0; j < 4; ++j) v[q][j] = xr[q][64 * j]; }
#pragma unroll
        for (int q = 0; q < 3; ++q) {
            const float* md = mods_l + (size_t)modrow(rw[q]) * 6144 + shoff;
            float s = 0.f;
#pragma unroll
            for (int j = 0; j < 4; ++j) s += (v[q][j].x * v[q][j].x + v[q][j].y * v[q][j].y) + (v[q][j].z * v[q][j].z + v[q][j].w * v[q][j].w);
            const float r = 1.0f / sqrtf(wave_sum(s, F.lane) * (1.f / DMODEL) + EPS);
            unsigned long long* o8 = (unsigned long long*)(H + (size_t)rw[q] * DMODEL) + F.lane;
#pragma unroll
            for (int j = 0; j < 4; ++j) { const f32x4 sh = *((const f32x4*)md + F.lane + 64 * j), sc = *((const f32x4*)(md + 1024) + F.lane + 64 * j);
                const float y0 = v[q][j].x * r * (1.f + sc.x) + sh.x, y1 = v[q][j].y * r * (1.f + sc.y) + sh.y, y2 = v[q][j].z * r * (1.f + sc.z) + sh.z, y3 = v[q][j].w * r * (1.f + sc.w) + sh.w;
                if (ok[q]) o8[64 * j] = (unsigned long long)pk2(y0, y1) | ((unsigned long long)pk2(y2, y3) << 32); }
        }
    }
}

__device__ __forceinline__ void weights_phase(Frame& F0, const Args& a, int l) {
    Frame F = F0; { int t_ = F0.wave0 * 64 + lane_asm(); asm volatile("" : "+v"(t_)); F.tid = t_; F.lane = t_ & 63; F.wave = __builtin_amdgcn_readfirstlane(t_ >> 6); } int lz = 0; asm volatile("" : "+s"(lz)); unsigned char* wsl = (unsigned char*)((unsigned long long)a.ws ^ (unsigned long long)(unsigned)lz);
    unsigned char* ws = wsl; const int even = !(l & 1), i = l >> 1;
    const int nin = even ? NIN_E : NIN_O;
    const float* win = even ? a.in[lz + I_WINE] + (size_t)i * 1024 * NIN_E : a.in[lz + I_WINO] + (size_t)i * 1024 * NIN_O;
    const float* wout = (even ? a.in[lz + I_WOUTE] : a.in[lz + I_WOUTO]) + (size_t)i * 1024 * 1024;
    const float* wup = a.in[lz + I_WUP] + (size_t)l * 1024 * NUP;
    const float* wdown = a.in[lz + I_WDOWN] + (size_t)l * FFH * 1024;
    LAS float* scr = (LAS float*)(F.lds + F.wave * 16384);
    const int n_in = 16 * (nin / 32), n_out = 16 * 32, n_up = 16 * (NUP / 32), n_down = (FFH / 64) * 32;
    const int gw = F.bid * NWAVES + F.wave, NGW = F.G * NWAVES;
    for (int it = gw; it < n_in + n_out + n_up + n_down; it += NGW) {
        int r = it;
        if (r < n_in) { transpose_item(win, 1024, nin, (bf16*)(ws + WS_WIN), scr, r, F.lane); continue; } r -= n_in;
        if (r < n_out) { transpose_item(wout, 1024, 1024, (bf16*)(ws + WS_WOUT), scr, r, F.lane); continue; } r -= n_out;
        if (r < n_up) { transpose_item(wup, 1024, NUP, (bf16*)(ws + WS_WUP), scr, r, F.lane, true); continue; } r -= n_up;
        transpose_item(wdown, FFH, 1024, (bf16*)(ws + WS_WDOWN), scr, r, F.lane);
    }
}

__device__ __forceinline__ void filter_phase(Frame& F0, const Args& a, int l) {
    Frame F = F0; { int t_ = F0.wave0 * 64 + lane_asm(); asm volatile("" : "+v"(t_)); F.tid = t_; F.lane = t_ & 63; F.wave = __builtin_amdgcn_readfirstlane(t_ >> 6); } int lz = 0; asm volatile("" : "+s"(lz)); unsigned char* wsl = (unsigned char*)((unsigned long long)a.ws ^ (unsigned long long)(unsigned)lz);
    unsigned char* ws = wsl; const int i = l >> 1;
    const float* H3L = (const float*)(ws + WS_H3L); const float* H3C = (const float*)(ws + WS_H3C);
    float* FILT = (float*)(ws + WS_FILT); float* FILTC = (float*)(ws + WS_FILTC); float* PART = (float*)(ws + WS_PART);
    const float* w4 = a.in[lz + I_HW4] + (size_t)i * 64 * 1024;
    const float mind = logf(1e-2f) / 1.5f, maxd = logf(1e-2f) / 0.3f;
    LAS float* hs = (LAS float*)(F.lds + F.wave * 16896);
    const int nitem = 2048 + (l == 1 ? 64 : 0);
    const int gw = F.bid * NWAVES + F.wave, NGW = F.G * NWAVES;
    for (int it = gw; it < nitem; it += NGW) {
        const int type = it >= 2048 ? 1 : 0, r = type ? it - 2048 : it, cg = r & 15, chunk = r >> 4, L = type ? 256 : 8192;
        const float* h3 = (type ? H3C + (size_t)i * 256 * 64 : H3L + (size_t)i * 8192 * 64) + (size_t)chunk * 64 * 64;
#pragma unroll 4
        for (int j = 0; j < 16; ++j) { const int e4 = (j * 64 + F.lane) * 4; const f32x4 v = *(const f32x4*)(h3 + e4); LAS float* d = hs + (e4 >> 6) * 65 + (e4 & 63); d[0] = v.x; d[1] = v.y; d[2] = v.z; d[3] = v.w; }
        LDS_WAIT();
        const int p = chunk * 64 + F.lane;
        const float tt = (float)p / (float)(L - 1);
        float acc[32], acb[32];
#pragma unroll
        for (int cc = 0; cc < 32; ++cc) { acc[cc] = 0.f; acb[cc] = 0.f; }
        const float* wrow = w4 + cg * 32 + (F.lane < 32 ? F.lane : 512 + F.lane - 32);
#pragma unroll 2
        for (int k = 0; k < 64; ++k) { const float hv = hs[F.lane * 65 + k]; const float wk = wrow[k * 1024];
#pragma unroll
            for (int cc = 0; cc < 32; ++cc) { acc[cc] += hv * __builtin_bit_cast(float, __builtin_amdgcn_readlane(__builtin_bit_cast(int, wk), cc));
                                              acb[cc] += hv * __builtin_bit_cast(float, __builtin_amdgcn_readlane(__builtin_bit_cast(int, wk), 32 + cc)); } }
        float mys = 0.f;
#pragma unroll
        for (int cc = 0; cc < 32; ++cc) {
            const int c = cg * 32 + cc;
            const float delta = fabsf(mind + (float)c * ((maxd - mind) / 511.f)), decay = expf(-tt * delta);
            const float hf = acc[cc] * decay, hb = acb[cc] * decay;
            if (type) { FILTC[(size_t)c * 512 + p] = hf; FILTC[(size_t)c * 512 + 256 + p] = hb; }
            else { FILT[(size_t)c * 16384 + p] = hf; FILT[(size_t)c * 16384 + 8192 + p] = hb; }
            float s = fabsf(hf) + (p >= 1 ? fabsf(hb) : 0.f); s = wave_sum(s, F.lane);
            mys = (F.lane == cc) ? s : mys;
        }
        if (F.lane < 32) PART[(size_t)(type * 128 + chunk) * 512 + cg * 32 + F.lane] = mys;
        LDS_WAIT();
    }
}

__device__ __forceinline__ v4u qk_compute(v4u w, const float* gain, bool isq, bool rope, const float* rp, int lane) {
    float x[8] = {bflo(w.x), bfhi(w.x), bflo(w.y), bfhi(w.y), bflo(w.z), bfhi(w.z), bflo(w.w), bfhi(w.w)};
    float ss = 0.f;
#pragma unroll
    for (int e = 0; e < 8; ++e) ss += x[e] * x[e];
    ss += shfl_l(ss, lane ^ 1); ss += shfl_l(ss, lane ^ 2); ss += shfl_l(ss, lane ^ 4);
    const float r = 1.0f / sqrtf(ss * (1.f / 64.f) + EPS);
    const f32x4 g0 = *(const f32x4*)(gain + (lane & 7) * 8), g1 = *(const f32x4*)(gain + (lane & 7) * 8 + 4);
    x[0] *= r * g0.x; x[1] *= r * g0.y; x[2] *= r * g0.z; x[3] *= r * g0.w; x[4] *= r * g1.x; x[5] *= r * g1.y; x[6] *= r * g1.z; x[7] *= r * g1.w;
    if (rope) { const f32x4 c0 = *(const f32x4*)(rp + (lane & 7) * 8), c1 = *(const f32x4*)(rp + (lane & 7) * 8 + 4);
        float t0;
        t0 = x[0] * c0.x - x[1] * c0.y; x[1] = x[0] * c0.y + x[1] * c0.x; x[0] = t0;
        t0 = x[2] * c0.z - x[3] * c0.w; x[3] = x[2] * c0.w + x[3] * c0.z; x[2] = t0;
        t0 = x[4] * c1.x - x[5] * c1.y; x[5] = x[4] * c1.y + x[5] * c1.x; x[4] = t0;
        t0 = x[6] * c1.z - x[7] * c1.w; x[7] = x[6] * c1.w + x[7] * c1.z; x[6] = t0; }
    if (isq) {
#pragma unroll
        for (int e = 0; e < 8; ++e) x[e] *= QSCALE; }
    v4u o; o.x = pk2(x[0], x[1]); o.y = pk2(x[2], x[3]); o.z = pk2(x[4], x[5]); o.w = pk2(x[6], x[7]); return o;
}
__device__ __forceinline__ void qknorm_phase(Frame& F0, const Args& a, int l, bf16* U, int dry = 0) {
    Frame F = F0; { int t_ = F0.wave0 * 64 + lane_asm(); asm volatile("" : "+v"(t_)); F.tid = t_; F.lane = t_ & 63; F.wave = __builtin_amdgcn_readfirstlane(t_ >> 6); } int lz = 0; asm volatile("" : "+s"(lz)); unsigned char* wsl = (unsigned char*)((unsigned long long)a.ws ^ (unsigned long long)(unsigned)lz);
    const int even = !(l & 1), i = l >> 1, pitch = even ? NIN_E : NIN_O;
    const float* ROPE = (const float*)(wsl + WS_ROPE);
    const int gw = F.bid * NWAVES + F.wave, NGW = F.G * NWAVES;
    if (even) {
        const float *g0 = a.in[lz + I_NAQG] + i * 64, *g1 = a.in[lz + I_NAKG] + i * 64, *g2 = a.in[lz + I_DAQG] + i * 64, *g3 = a.in[lz + I_DAKG] + i * 64;
        for (int row = gw; row < MROWS; row += 2 * NGW) {
            const int row1 = row + NGW; const bool has1 = row1 < MROWS;
            bf16* u0 = U + (size_t)row * pitch + F.lane * 8; bf16* u1 = U + (size_t)(has1 ? row1 : row) * pitch + F.lane * 8;
            const v4u a0 = *(const v4u*)u0, a1 = *(const v4u*)(u0 + 512), a2 = *(const v4u*)(u0 + 1536), a3 = *(const v4u*)(u0 + 2048);
            const v4u b0 = *(const v4u*)u1, b1 = *(const v4u*)(u1 + 512), b2 = *(const v4u*)(u1 + 1536), b3 = *(const v4u*)(u1 + 2048);
            const int t0 = row % TPB, t1 = (has1 ? row1 : row) % TPB; const bool l0 = t0 < SEQ, l1 = t1 < SEQ;
            const float* rp0 = ROPE + (size_t)(l0 ? t0 : 0) * 64; const float* rp1 = ROPE + (size_t)(l1 ? t1 : 0) * 64;
            const v4u o0 = qk_compute(a0, g0, true, false, rp0, F.lane), o1 = qk_compute(a1, g1, false, false, rp0, F.lane), o2 = qk_compute(a2, g2, true, l0, rp0, F.lane), o3 = qk_compute(a3, g3, false, l0, rp0, F.lane);
            const v4u p0 = qk_compute(b0, g0, true, false, rp1, F.lane), p1 = qk_compute(b1, g1, false, false, rp1, F.lane), p2 = qk_compute(b2, g2, true, l1, rp1, F.lane), p3 = qk_compute(b3, g3, false, l1, rp1, F.lane);
            if (dry && (o0.x ^ o1.x ^ o2.x ^ o3.x ^ p0.x ^ p1.x ^ p2.x ^ p3.x) != 0x12345678u) continue;
            *(v4u*)u0 = o0; *(v4u*)(u0 + 512) = o1; *(v4u*)(u0 + 1536) = o2; *(v4u*)(u0 + 2048) = o3;
            if (has1) { *(v4u*)u1 = p0; *(v4u*)(u1 + 512) = p1; *(v4u*)(u1 + 1536) = p2; *(v4u*)(u1 + 2048) = p3; }
        }
    } else {
        const float *g0 = a.in[lz + I_GQG] + i * 64, *g1 = a.in[lz + I_GKG] + i * 64;
        const bool kact = F.lane < 16;
        for (int row = gw; row < MROWS; row += 2 * NGW) {
            const int row1 = row + NGW; const bool has1 = row1 < MROWS;
            bf16* u0 = U + (size_t)row * pitch + F.lane * 8; bf16* u1 = U + (size_t)(has1 ? row1 : row) * pitch + F.lane * 8;
            const v4u zero = {0u, 0u, 0u, 0u};
            const v4u a0 = *(const v4u*)u0, a1 = kact ? *(const v4u*)(u0 + 512) : zero;
            const v4u b0 = *(const v4u*)u1, b1 = kact ? *(const v4u*)(u1 + 512) : zero;
            const int t0 = row % TPB, t1 = (has1 ? row1 : row) % TPB; const bool l0 = t0 < SEQ, l1 = t1 < SEQ;
            const float* rp0 = ROPE + (size_t)(l0 ? t0 : 0) * 64; const float* rp1 = ROPE + (size_t)(l1 ? t1 : 0) * 64;
            const v4u o0 = qk_compute(a0, g0, true, l0, rp0, F.lane), o1 = qk_compute(a1, g1, false, l0, rp0, F.lane);
            const v4u p0 = qk_compute(b0, g0, true, l1, rp1, F.lane), p1 = qk_compute(b1, g1, false, l1, rp1, F.lane);
            if (dry && (o0.x ^ o1.x ^ p0.x ^ p1.x) != 0x12345678u) continue;
            *(v4u*)u0 = o0; if (kact) *(v4u*)(u0 + 512) = o1;
            if (has1) { *(v4u*)u1 = p0; if (kact) *(v4u*)(u1 + 512) = p1; }
        }
    }
}
__device__ __forceinline__ void hyprep_phase(Frame& F0, const Args& a, int l, const bf16* U) {
    Frame F = F0; { int t_ = F0.wave0 * 64 + lane_asm(); asm volatile("" : "+v"(t_)); F.tid = t_; F.lane = t_ & 63; F.wave = __builtin_amdgcn_readfirstlane(t_ >> 6); } int lz = 0; asm volatile("" : "+s"(lz)); unsigned char* wsl = (unsigned char*)((unsigned long long)a.ws ^ (unsigned long long)(unsigned)lz);
    const int i = l >> 1;
    bf16* ZT = (bf16*)(wsl + WS_ZT); bf16* X0T = (bf16*)(wsl + WS_X0T);
    LAS bf16* zs = (LAS bf16*)F.lds; LAS bf16* xs = zs + 128 * 66;
    if (F.bid == (F.G > 1 ? 1 : 0)) { float* INV = (float*)(wsl + WS_PART) + 132 * 512; const float* PART = (const float*)(wsl + WS_PART);
        { float s = 0.f; for (int k = 0; k < 128; ++k) s += PART[(size_t)k * 512 + F.tid]; INV[F.tid] = 1.0f / s; }
        if (l == 1) { float s = 0.f; for (int k = 0; k < 4; ++k) s += PART[(size_t)(128 + k) * 512 + F.tid]; INV[512 + F.tid] = 1.0f / s; } }
    const float* cw = a.in[lz + I_HCW] + (size_t)i * 3 * 1536; const float* cb = a.in[lz + I_HCB] + (size_t)i * 1536;
    const int cp = F.tid & 63, tq = F.tid >> 6;
    for (int it = F.bid; it < 2048; it += F.G) {
        const int cgp = it & 3, tile = it >> 2, b = tile >> 7, t0 = (tile & 127) * 64;
        const size_t rowb = (size_t)b * TPB;
        const int tb = t0 + tq * 8;
        float res[3][8][2];
#pragma unroll
        for (int part = 0; part < 3; ++part) {
            const int cc = part * 512 + cgp * 128 + 2 * cp;
            const float w0a = cw[cc], w0b = cw[cc + 1], w1a = cw[1536 + cc], w1b = cw[1536 + cc + 1], w2a = cw[3072 + cc], w2b = cw[3072 + cc + 1], ba = cb[cc], bb = cb[cc + 1];
            unsigned ua[10];
#pragma unroll
            for (int k = 0; k < 10; ++k) { const int tt = tb - 1 + k; ua[k] = (tt >= 0 && tt < SEQ) ? *(const unsigned*)(U + (rowb + tt) * NIN_O + 768 + cc) : 0u; }
#pragma unroll
            for (int k = 0; k < 8; ++k) { res[part][k][0] = w0a * bflo(ua[k]) + w1a * bflo(ua[k + 1]) + w2a * bflo(ua[k + 2]) + ba;
                                          res[part][k][1] = w0b * bfhi(ua[k]) + w1b * bfhi(ua[k + 1]) + w2b * bfhi(ua[k + 2]) + bb; }
        }
#pragma unroll
        for (int k = 0; k < 8; ++k) {
            zs[(2 * cp) * 66 + tq * 8 + k] = (bf16)f2bf(res[2][k][0] * res[1][k][0]); zs[(2 * cp + 1) * 66 + tq * 8 + k] = (bf16)f2bf(res[2][k][1] * res[1][k][1]);
            xs[(2 * cp) * 66 + tq * 8 + k] = (bf16)f2bf(res[0][k][0]);               xs[(2 * cp + 1) * 66 + tq * 8 + k] = (bf16)f2bf(res[0][k][1]);
        }
        __syncthreads();
        { const int c = F.tid >> 2, q = F.tid & 3; const size_t go = (size_t)(cgp * 128 + c) * (NBATCH * SEQ) + (size_t)b * SEQ + t0 + q * 16;
          const LAS unsigned* zr = (const LAS unsigned*)(zs + c * 66 + q * 16); const LAS unsigned* xr = (const LAS unsigned*)(xs + c * 66 + q * 16);
          v4u z0 = {zr[0], zr[1], zr[2], zr[3]}, z1 = {zr[4], zr[5], zr[6], zr[7]}, x0 = {xr[0], xr[1], xr[2], xr[3]}, x1 = {xr[4], xr[5], xr[6], xr[7]};
          *(v4u*)(ZT + go) = z0; *(v4u*)(ZT + go + 8) = z1; *(v4u*)(X0T + go) = x0; *(v4u*)(X0T + go + 8) = x1; }
        __syncthreads();
    }
}

struct DenseMap { static constexpr bool HAS_MASK = false;
    __device__ __forceinline__ int row(int t) const { return 64 * t; }
    __device__ __forceinline__ void mask(f32x16&, f32x16&, int, int, int) const {} };
struct NaMap { static constexpr bool HAS_MASK = true; int rlo, qr0; const LAS float* tab;
    __device__ __forceinline__ int row(int t) const { const int kr = rlo + t - 4; return t < 4 ? SEQ + 64 * t : (kr > 127 ? 127 : kr) * 64; }
    __device__ __forceinline__ void mask(f32x16& p0, f32x16& p1, int t, int qrel, int hi) const {
        if (t < 4) return;
        const int kr = rlo + t - 4, qr = qr0 + (qrel >> 6), r0q = (qr - 4 < 0) ? 0 : (qr - 4 > 120 ? 120 : qr - 4);
        const bool rowok = (kr >= r0q) && (kr <= r0q + 7);
        const int qc = qrel & 63, c0 = (qc - 8 < 0) ? 0 : (qc - 8 > 48 ? 48 : qc - 8);
        const float NEG = -INFINITY;
        if (!rowok) {
#pragma unroll
            for (int r = 0; r < 16; ++r) { p0[r] = NEG; p1[r] = NEG; }
        } else {
            const LAS float* tb = tab + (kr - qr + 7) * 31 + 15 - qc;
#pragma unroll
            for (int r = 0; r < 16; ++r) { const int kc = (r & 3) + 8 * (r >> 2) + 4 * hi;
                const bool ok0 = (unsigned)(kc - c0) < 16u, ok1 = (unsigned)(kc + 32 - c0) < 16u;
                const float b0 = tb[kc], b1 = tb[kc + 32];
                p0[r] = ok0 ? p0[r] + b0 : NEG; p1[r] = ok1 ? p1[r] + b1 : NEG; }
        }
    } };

__device__ __forceinline__ int q_next(Frame& F, unsigned* ctr, int x, int nloc) {
    volatile LAS int* w = (volatile LAS int*)(F.lds + MISC_OFF);
    __syncthreads();
    if (F.tid == 0) { int res = -1;
        for (int k = 0; k < 8; ++k) { const int xx = (x + k) & 7; const unsigned n = atomicAdd(ctr + xx * 64, 1u); if (n < (unsigned)nloc) { res = xx * 65536 + (int)n; break; } }
        w[0] = res; }
    __syncthreads();
    return __builtin_amdgcn_readfirstlane(w[0]);
}

__device__ __forceinline__ void hyena_unit(Frame& F0, const Args& a, int l, int c, int dry) {
    Frame F = F0; { int t_ = F0.wave0 * 64 + lane_asm(); asm volatile("" : "+v"(t_)); F.tid = t_; F.lane = t_ & 63; F.wave = __builtin_amdgcn_readfirstlane(t_ >> 6); } int lz = 0; asm volatile("" : "+s"(lz)); unsigned char* wsl = (unsigned char*)((unsigned long long)a.ws ^ (unsigned long long)(unsigned)lz);
    const int i = l >> 1;
    const float* FILT = (const float*)(wsl + WS_FILT) + (size_t)c * 16384;
    const bf16* ZT = (const bf16*)(wsl + WS_ZT) + (size_t)c * (NBATCH * SEQ); bf16* X0T = (bf16*)(wsl + WS_X0T) + (size_t)c * (NBATCH * SEQ);
    const float inv = ((const float*)(wsl + WS_PART) + 132 * 512)[c];
    const float skipc = a.in[lz + I_HSKIP][i * 512 + c];
    LAS bf16* RA = (LAS bf16*)F.lds;
    LAS bf16* RB = (LAS bf16*)(F.lds + 32768 + 64);
    LAS bf16* zl = (LAS bf16*)(F.lds + 65536 + 64);
#define HY_ZIDX(bq_, t_) ((bq_) * 8736 + ((t_) >> 7) * 136 + ((t_) & 127))
    f32x4 fv[4], fw[4]; v4u zq[8];
#pragma unroll
    for (int q = 0; q < 4; ++q) { const int j = F.tid * 4 + q * NTHREADS * 4; fv[q] = *(const f32x4*)(FILT + j); fw[q] = *(const f32x4*)(FILT + 8192 + j); }
#pragma unroll
    for (int q = 0; q < 8; ++q) zq[q] = *(const v4u*)(ZT + F.tid * 8 + q * NTHREADS * 8);
#pragma unroll
    for (int q = 0; q < 4; ++q) { const int j = F.tid * 4 + q * NTHREADS * 4; const f32x4 vf = fv[q], vb = fw[q];
        const float ff[4] = {vf.x, vf.y, vf.z, vf.w}, fb[4] = {vb.x, vb.y, vb.z, vb.w};
#pragma unroll
        for (int e = 0; e < 4; ++e) { const int pp = j + e; const bf16 hf = (bf16)f2bf(ff[e] * inv), hb = (bf16)f2bf(fb[e] * inv);
            RA[8191 - pp] = hf; if (8191 - pp >= 1) RB[8190 - pp] = hf;
            if (pp >= 1) { RA[8191 + pp] = hb; RB[8190 + pp] = hb; } } }
#pragma unroll
    for (int q = 0; q < 8; ++q) { const int j = F.tid * 8 + q * NTHREADS * 8; *(LAS v4u*)(zl + HY_ZIDX(j >> 13, j & 8191)) = zq[q]; }
    __syncthreads();
    const int w = F.wave, n = F.lane & 31, kg = F.lane >> 5, ii = 8 * w + (n >> 2), bb = n & 3;
    const unsigned abase = (n & 1) ? (unsigned)(uintptr_t)(RA + (8191 - n + 8 * kg)) : (unsigned)(uintptr_t)(RB + (8190 - n + 8 * kg));
    f32x16 acc[4];
#pragma unroll
    for (int m = 0; m < 4; ++m) acc[m] = f32x16{};
    v2u af[14][2], an[8][2]; v4u bq[8], bn[8];
#define HY_LDA(dst, g, addr) do { asm volatile("ds_read2_b32 %0, %1 offset0:%2 offset1:%3" : "=v"(dst[0]) : "v"(addr), "n"(104 - 8 * (g)), "n"(105 - 8 * (g)) : "memory"); \
                                  asm volatile("ds_read2_b32 %0, %1 offset0:%2 offset1:%3" : "=v"(dst[1]) : "v"(addr), "n"(106 - 8 * (g)), "n"(107 - 8 * (g)) : "memory"); } while (0)
#define HY_LDB(dst, ks, zaddr) asm volatile("ds_read_b128 %0, %1 offset:%2" : "=v"(dst) : "v"(zaddr), "n"((ks) * 32) : "memory")
#define HY_ISSUE(dd) do { const unsigned addr_ = abase + (unsigned)((-64 * (dd) - 48) * 4);     \
        HY_LDA(an[0], 6, addr_); HY_LDA(an[1], 7, addr_); HY_LDA(an[2], 8, addr_); HY_LDA(an[3], 9, addr_); HY_LDA(an[4], 10, addr_); HY_LDA(an[5], 11, addr_); HY_LDA(an[6], 12, addr_); HY_LDA(an[7], 13, addr_); \
        const int jb_ = ii - (dd); const unsigned zaddr_ = (unsigned)(uintptr_t)(zl + bb * 8736 + ((unsigned)jb_ < 64u ? jb_ : 0) * 136 + kg * 8); \
        HY_LDB(bn[0], 0, zaddr_); HY_LDB(bn[1], 1, zaddr_); HY_LDB(bn[2], 2, zaddr_); HY_LDB(bn[3], 3, zaddr_); HY_LDB(bn[4], 4, zaddr_); HY_LDB(bn[5], 5, zaddr_); HY_LDB(bn[6], 6, zaddr_); HY_LDB(bn[7], 7, zaddr_); } while (0)
    const int d0 = 8 * w - 63, dlast = 8 * w + 7;
    { const unsigned addr = abase + (unsigned)((-64 * d0 - 48) * 4);
      HY_LDA(af[8], 0, addr); HY_LDA(af[9], 1, addr); HY_LDA(af[10], 2, addr); HY_LDA(af[11], 3, addr); HY_LDA(af[12], 4, addr); HY_LDA(af[13], 5, addr); }
    HY_ISSUE(d0);
    for (int d = d0; d <= dlast; ++d) {
        asm volatile("s_waitcnt lgkmcnt(0)" ::: "memory");
#pragma unroll
        for (int g = 8; g < 14; ++g) asm volatile("" : "+v"(af[g][0]), "+v"(af[g][1]));
#pragma unroll
        for (int g = 0; g < 8; ++g) asm volatile("" : "+v"(an[g][0]), "+v"(an[g][1]), "+v"(bn[g]));
#pragma unroll
        for (int g = 0; g < 6; ++g) { af[g][0] = af[g + 8][0]; af[g][1] = af[g + 8][1]; }
#pragma unroll
        for (int g = 0; g < 8; ++g) { af[6 + g][0] = an[g][0]; af[6 + g][1] = an[g][1]; bq[g] = bn[g]; }
#pragma unroll
        for (int g = 0; g < 14; ++g) asm volatile("" : "+v"(af[g][0]), "+v"(af[g][1]));
#pragma unroll
        for (int g = 0; g < 8; ++g) asm volatile("" : "+v"(bq[g]));
        if (d < dlast) HY_ISSUE(d + 1);
        const int jb = ii - d; const bool valid = (unsigned)jb < 64u;
#pragma unroll
        for (int ks = 0; ks < 8; ++ks) {
            bf16x8 bfr = __builtin_bit_cast(bf16x8, bq[ks]);
            if (!valid) bfr = bf16x8{};
#pragma unroll
            for (int mt = 0; mt < 4; ++mt) { const int g = 2 * mt - ks + 7; const v4u aw = {af[g][0].x, af[g][0].y, af[g][1].x, af[g][1].y};
                acc[mt] = __builtin_amdgcn_mfma_f32_32x32x16_bf16(__builtin_bit_cast(bf16x8, aw), bfr, acc[mt], 0, 0, 0); }
        }
    }
#undef HY_LDA
#undef HY_LDB
#undef HY_ISSUE
    __syncthreads();
    LAS bf16* yt = (LAS bf16*)F.lds + w * 4096;
#pragma unroll
    for (int mt = 0; mt < 4; ++mt)
#pragma unroll
        for (int v = 0; v < 16; ++v) { const int tl = (n >> 2) * 128 + 32 * mt + (v & 3) + 8 * (v >> 2) + 4 * kg; yt[bb * 1024 + (tl & ~127) + ((((tl & 127) >> 3) ^ (n >> 2)) << 3) + (tl & 7)] = (bf16)f2bf(acc[mt][v]); }
    LDS_WAIT();
#pragma unroll
    for (int it = 0; it < 8; ++it) { const int e = (it * 64 + F.lane) * 8, b2 = e >> 10, tl = e & 1023; const size_t go = (size_t)b2 * SEQ + 1024 * w + tl;
        const v4u xv = *(const v4u*)(X0T + go), zv = *(const LAS v4u*)(zl + HY_ZIDX(b2, 1024 * w + tl)), yv = *(const LAS v4u*)(yt + (e & ~127) + ((((e & 127) >> 3) ^ ((e >> 7) & 7)) << 3));
        const unsigned xa[4] = {xv.x, xv.y, xv.z, xv.w}, za[4] = {zv.x, zv.y, zv.z, zv.w}, ya[4] = {yv.x, yv.y, yv.z, yv.w}; unsigned oo[4];
#pragma unroll
        for (int q = 0; q < 4; ++q) oo[q] = pk2(bflo(xa[q]) * (bflo(ya[q]) + skipc * bflo(za[q])), bfhi(xa[q]) * (bfhi(ya[q]) + skipc * bfhi(za[q])));
        if (dry && oo[0] != 0x12345678u) { oo[0] = xa[0]; oo[1] = xa[1]; oo[2] = xa[2]; oo[3] = xa[3]; }
        *(v4u*)(X0T + go) = (v4u){oo[0], oo[1], oo[2], oo[3]}; }
}
#undef HY_ZIDX

__device__ __forceinline__ void hyena_ctx_item(Frame& F0, const Args& a, int l, int item, const bf16* U) {
    Frame F = F0; { int t_ = F0.wave0 * 64 + lane_asm(); asm volatile("" : "+v"(t_)); F.tid = t_; F.lane = t_ & 63; F.wave = __builtin_amdgcn_readfirstlane(t_ >> 6); } int lz = 0; asm volatile("" : "+s"(lz)); unsigned char* wsl = (unsigned char*)((unsigned long long)a.ws ^ (unsigned long long)(unsigned)lz);
    const int i = l >> 1, c = item * 8 + F.wave, lane = F.lane;
    LAS float* fl = (LAS float*)(F.lds + F.wave * 16384);
    LAS float* zl = fl + 512;
    LAS float* xl = zl + 1024;
    const float* FILTC = (const float*)(wsl + WS_FILTC) + (size_t)c * 512;
    const float inv = ((const float*)(wsl + WS_PART) + 132 * 512 + 512)[c];
    const float skipc = a.in[lz + I_HSKIP][i * 512 + c];
    bf16* YTC = (bf16*)(wsl + WS_YTC) + (size_t)c * 1024;
    const float* cw = a.in[lz + I_HCW] + (size_t)i * 3 * 1536; const float* cb = a.in[lz + I_HCB] + (size_t)i * 1536;
    for (int j = lane; j < 256; j += 64) { fl[255 + j] = FILTC[j] * inv; if (j > 0) fl[255 - j] = FILTC[256 + j] * inv; }
    if (lane == 0) fl[511] = 0.f;
    for (int b = 0; b < 4; ++b)
        for (int k = 0; k < 4; ++k) { const int t = lane + 64 * k; float r3[3];
#pragma unroll
            for (int part = 0; part < 3; ++part) { const int cc = part * 512 + c; const bf16* up = U + ((size_t)b * TPB + SEQ + t) * NIN_O + 768 + cc;
                const float um = t > 0 ? bf2f(up[-NIN_O]) : 0.f, u0 = bf2f(up[0]), u1 = t < 255 ? bf2f(up[NIN_O]) : 0.f;
                r3[part] = cw[cc] * um + cw[1536 + cc] * u0 + cw[3072 + cc] * u1 + cb[cc]; }
            zl[b * 256 + t] = r3[2] * r3[1]; xl[b * 256 + t] = r3[0]; }
    LDS_WAIT();
    for (int k = 0; k < 4; ++k) { const int t = lane + 64 * k; float y0 = 0.f, y1 = 0.f, y2 = 0.f, y3 = 0.f;
        for (int s = 0; s < 256; ++s) { const float f = fl[t - s + 255]; y0 += f * zl[s]; y1 += f * zl[256 + s]; y2 += f * zl[512 + s]; y3 += f * zl[768 + s]; }
        const float yy[4] = {y0, y1, y2, y3};
#pragma unroll
        for (int b = 0; b < 4; ++b) YTC[b * 256 + t] = (bf16)f2bf(xl[b * 256 + t] * (yy[b] + skipc * zl[b * 256 + t])); }
}

__device__ __forceinline__ void mixer_phase(Frame& F0, const Args& a, int l, char* ldsg, int qslot, int dry) {
    Frame F = F0; { int t_ = F0.wave0 * 64 + lane_asm(); asm volatile("" : "+v"(t_)); F.tid = t_; F.lane = t_ & 63; F.wave = __builtin_amdgcn_readfirstlane(t_ >> 6); } int lz = 0; asm volatile("" : "+s"(lz)); unsigned char* wsl = (unsigned char*)((unsigned long long)a.ws ^ (unsigned long long)(unsigned)lz);
    using abf = attn_body::bf16;
    const int even = !(l & 1), i = l >> 1;
    unsigned* ctr = (unsigned*)(wsl + WS_CTL) + CW_QUEUE + 512 * qslot;
    const int xcd = (int)(xb_xcc_id() & 7u);
    const bf16* U = (const bf16*)(wsl + WS_U); bf16* MIX = (bf16*)(wsl + WS_H); bf16* DAO = (bf16*)(wsl + WS_DAO);
    const int nloc = even ? 396 : (l == 1 ? 204 : 196);
    LAS float* tab = (LAS float*)(F.lds + 86016);
    for (;;) {
        const int qv = q_next(F, ctr, xcd, nloc);
        if (qv < 0) break;
        int id; { const int xx = qv >> 16, n = qv & 65535;
            if (even) { if (n < 256) id = (8 * (n >> 5) + xx) * 32 + (n & 31);
                        else if (n < 384) id = 2048 + (8 * ((n - 256) >> 5) + xx) * 32 + (n & 31);
                        else if (n < 392) id = 3072 + 8 * (n - 384) + xx;
                        else id = 3136 + 8 * (n - 392) + xx; }
            else { if (n < 64) id = 8 * n + xx;
                   else if (n < 192) { const int m = n - 64, b = xx >> 1, h = (xx & 1) * 4 + (m >> 5); id = 512 + (b * 8 + h) * 32 + (m & 31); }
                   else if (n < 196) { const int b = xx >> 1, h = (xx & 1) * 4 + (n - 192); id = 1536 + b * 8 + h; }
                   else id = 1568 + 8 * (n - 196) + xx; } }
        const bf16 *Q, *K, *V; bf16* O; int pin, NT = 132, po = 1024; bool isna = false; int na_qb = 0, na_h = 0;
        if (even) {
            pin = NIN_E;
            if (id < 2048) { const int qb = id & 31, x = id >> 5, half = x & 1, comp = (x >> 1) & 1, hd = (x >> 2) & 3, b = x >> 4; const size_t rb = (size_t)b * TPB;
                Q = U + (rb + qb * 256) * NIN_E + 1536 + (2 * hd + comp) * 64; K = U + rb * NIN_E + 2048 + (2 * hd + comp) * 64; V = U + rb * NIN_E + 2560 + hd * 128 + half * 64;
                O = DAO + (rb + qb * 256) * 1024 + ((hd * 2 + comp) * 2 + half) * 64; }
            else if (id < 3072) { const int y = id - 2048, qb = y & 31, h = (y >> 5) & 7, b = y >> 8; const size_t rb = (size_t)b * TPB;
                Q = U + (rb + qb * 256) * NIN_E + h * 64; K = U + rb * NIN_E + 512 + h * 64; V = U + rb * NIN_E + 1024 + h * 64; O = MIX + (rb + qb * 256) * 1024 + h * 64;
                NT = 16; isna = true; na_qb = qb; na_h = h; }
            else if (id < 3136) { const int x = id - 3072, half = x & 1, comp = (x >> 1) & 1, hd = (x >> 2) & 3, b = x >> 4; const size_t rb = (size_t)b * TPB + SEQ;
                Q = U + rb * NIN_E + 1536 + (2 * hd + comp) * 64; K = U + rb * NIN_E + 2048 + (2 * hd + comp) * 64; V = U + rb * NIN_E + 2560 + hd * 128 + half * 64;
                O = DAO + rb * 1024 + ((hd * 2 + comp) * 2 + half) * 64; NT = 4; }
            else { const int x = id - 3136, h = x & 7, b = x >> 3; const size_t rb = (size_t)b * TPB + SEQ;
                Q = U + rb * NIN_E + h * 64; K = U + rb * NIN_E + 512 + h * 64; V = U + rb * NIN_E + 1024 + h * 64; O = MIX + rb * 1024 + h * 64; NT = 4; }
        } else {
            pin = NIN_O;
            if (id < 512) {
#ifndef NO_HYU
 hyena_unit(F, a, l, id, dry);
#endif
 continue; }
            else if (id < 1536) { const int y = id - 512, qb = y & 31, h = (y >> 5) & 7, b = y >> 8; const size_t rb = (size_t)b * TPB;
                Q = U + (rb + qb * 256) * NIN_O + h * 64; K = U + rb * NIN_O + 512 + (h >> 2) * 64; V = U + rb * NIN_O + 640 + (h >> 2) * 64; O = MIX + (rb + qb * 256) * 1024 + h * 64; }
            else if (id < 1568) { const int x = id - 1536, h = x & 7, b = x >> 3; const size_t rb = (size_t)b * TPB + SEQ;
                Q = U + rb * NIN_O + h * 64; K = U + rb * NIN_O + 512 + (h >> 2) * 64; V = U + rb * NIN_O + 640 + (h >> 2) * 64; O = MIX + rb * 1024 + h * 64; NT = 4; }
            else {
#ifndef NO_HYC
 hyena_ctx_item(F, a, l, id - 1568, U);
#endif
 continue; }
        }
        if (isna) {
            const float* rpb = a.in[lz + I_RPB] + ((size_t)i * 8 + na_h) * 465;
            { int t2 = F.tid; asm volatile("" : "+v"(t2)); if (t2 < 465) tab[t2] = rpb[t2] * 1.4426950408889634f; }
            NaMap tm; const int r4 = 4 * na_qb; tm.rlo = (r4 - 4 < 0) ? 0 : (r4 - 4 > 120 ? 120 : r4 - 4); tm.qr0 = r4; tm.tab = tab;
#ifndef NO_NA
            attn_body::attn_unit<8, NaMap>((const abf*)Q, pin, (const abf*)K, pin, (const abf*)V, pin, (abf*)O, po, NT, tm, ldsg, F0.wave0);
#endif
        } else {
            DenseMap tm;
#ifndef NO_DENSE
            attn_body::attn_unit<8, DenseMap>((const abf*)Q, pin, (const abf*)K, pin, (const abf*)V, pin, (abf*)O, po, NT, tm, ldsg, F0.wave0);
#endif
        }
    }
}

__device__ __forceinline__ void hypost_phase(Frame& F0, const Args& a, int l) {
    Frame F = F0; { int t_ = F0.wave0 * 64 + lane_asm(); asm volatile("" : "+v"(t_)); F.tid = t_; F.lane = t_ & 63; F.wave = __builtin_amdgcn_readfirstlane(t_ >> 6); } int lz = 0; asm volatile("" : "+s"(lz)); unsigned char* wsl = (unsigned char*)((unsigned long long)a.ws ^ (unsigned long long)(unsigned)lz);
    const bf16* YT = (const bf16*)(wsl + WS_X0T); const bf16* YTC = (const bf16*)(wsl + WS_YTC); bf16* MIX = (bf16*)(wsl + WS_H);
    LAS bf16* zs = (LAS bf16*)F.lds;
    const int ntile = 512 + (l == 1 ? 16 : 0);
    for (int it = F.bid; it < ntile * 4; it += F.G) {
        const int cgp = it & 3, tile = it >> 2;
        const bf16* src; size_t row0; int cstride;
        if (tile < 512) { const int b = tile >> 7, t0 = (tile & 127) * 64; src = YT + (size_t)b * SEQ + t0; cstride = NBATCH * SEQ; row0 = (size_t)b * TPB + t0; }
        else { const int x = tile - 512, b = x >> 2, t0 = (x & 3) * 64; src = YTC + b * 256 + t0; cstride = 1024; row0 = (size_t)b * TPB + SEQ + t0; }
        { const int c = F.tid >> 2, q = F.tid & 3; const bf16* sp = src + (size_t)(cgp * 128 + c) * cstride + q * 16;
          const v4u a0 = *(const v4u*)sp, a1 = *(const v4u*)(sp + 8); LAS unsigned* d = (LAS unsigned*)(zs + c * 66 + q * 16);
          d[0] = a0.x; d[1] = a0.y; d[2] = a0.z; d[3] = a0.w; d[4] = a1.x; d[5] = a1.y; d[6] = a1.z; d[7] = a1.w; }
        __syncthreads();
        { const int cp = F.tid & 63, tq = F.tid >> 6;
#pragma unroll
          for (int k = 0; k < 8; ++k) { const int t = tq * 8 + k; const unsigned lo = zs[(2 * cp) * 66 + t], hi = zs[(2 * cp + 1) * 66 + t];
              *(unsigned*)(MIX + (row0 + t) * 1024 + 512 + cgp * 128 + 2 * cp) = lo | (hi << 16); } }
        __syncthreads();
    }
}

__device__ __forceinline__ void dacombine_phase(Frame& F0, const Args& a, int l) {
    Frame F = F0; { int t_ = F0.wave0 * 64 + lane_asm(); asm volatile("" : "+v"(t_)); F.tid = t_; F.lane = t_ & 63; F.wave = __builtin_amdgcn_readfirstlane(t_ >> 6); } int lz = 0; asm volatile("" : "+s"(lz)); unsigned char* wsl = (unsigned char*)((unsigned long long)a.ws ^ (unsigned long long)(unsigned)lz);
    const int i = l >> 1; const float lam_init = 0.8f - 0.6f * expf(-0.3f * (float)l);
    const float s1 = wave_sum(a.in[lz + I_LQ1][i * 64 + F.lane] * a.in[lz + I_LK1][i * 64 + F.lane], F.lane), s2 = wave_sum(a.in[lz + I_LQ2][i * 64 + F.lane] * a.in[lz + I_LK2][i * 64 + F.lane], F.lane);
    const float lam = expf(s1) - expf(s2) + lam_init;
    const bf16* DAO = (const bf16*)(wsl + WS_DAO); bf16* MIX = (bf16*)(wsl + WS_H);
    const int hd = F.lane >> 4, d = (F.lane & 15) * 8, half = d >> 6, dd = d & 63;
    const float* sg = a.in[lz + I_SUBLN] + i * 128 + d;
    const f32x4 g0 = *(const f32x4*)sg, g1 = *(const f32x4*)(sg + 4);
    const float gg[8] = {g0.x, g0.y, g0.z, g0.w, g1.x, g1.y, g1.z, g1.w};
    const int gw = F.bid * NWAVES + F.wave, NGW = F.G * NWAVES;
    for (int row = gw; row < MROWS; row += NGW) {
        const v4u w1 = *(const v4u*)(DAO + (size_t)row * 1024 + ((hd * 2 + 0) * 2 + half) * 64 + dd), w2 = *(const v4u*)(DAO + (size_t)row * 1024 + ((hd * 2 + 1) * 2 + half) * 64 + dd);
        float y[8] = {bflo(w1.x) - lam * bflo(w2.x), bfhi(w1.x) - lam * bfhi(w2.x), bflo(w1.y) - lam * bflo(w2.y), bfhi(w1.y) - lam * bfhi(w2.y),
                      bflo(w1.z) - lam * bflo(w2.z), bfhi(w1.z) - lam * bfhi(w2.z), bflo(w1.w) - lam * bflo(w2.w), bfhi(w1.w) - lam * bfhi(w2.w)};
        float ss = 0.f;
#pragma unroll
        for (int e = 0; e < 8; ++e) ss += y[e] * y[e];
        ss += shfl_l(ss, F.lane ^ 1); ss += shfl_l(ss, F.lane ^ 2); ss += shfl_l(ss, F.lane ^ 4); ss += shfl_l(ss, F.lane ^ 8);
        const float r = (1.0f / sqrtf(ss * (1.f / 128.f) + EPS)) * (1.f - lam_init);
        v4u o; o.x = pk2(y[0] * r * gg[0], y[1] * r * gg[1]); o.y = pk2(y[2] * r * gg[2], y[3] * r * gg[3]); o.z = pk2(y[4] * r * gg[4], y[5] * r * gg[5]); o.w = pk2(y[6] * r * gg[6], y[7] * r * gg[7]);
        *(v4u*)(MIX + (size_t)row * 1024 + 512 + F.lane * 8) = o;
    }
}

__device__ __forceinline__ void convact_phase(Frame& F0, const Args& a, int l, int dry) {
    Frame F = F0; { int t_ = F0.wave0 * 64 + lane_asm(); asm volatile("" : "+v"(t_)); F.tid = t_; F.lane = t_ & 63; F.wave = __builtin_amdgcn_readfirstlane(t_ >> 6); } int lz = 0; asm volatile("" : "+s"(lz)); unsigned char* wsl = (unsigned char*)((unsigned long long)a.ws ^ (unsigned long long)(unsigned)lz);
    bf16* GV = (bf16*)(wsl + WS_GV);
    if (F.tid >= 352) return;
    const int j0 = F.tid * 8;
    const float* cw = a.in[lz + I_FCW] + (size_t)l * 3 * FFH + j0; const float* cb = a.in[lz + I_FCB] + (size_t)l * FFH + j0;
    float w0[8], w1[8], w2[8], bb[8];
#pragma unroll
    for (int e = 0; e < 8; ++e) { w0[e] = cw[e]; w1[e] = cw[FFH + e]; w2[e] = cw[2 * FFH + e]; bb[e] = cb[e]; }
    for (int it = F.bid; it < MROWS / 32; it += F.G) {
        const int r0 = it * 32, ts = r0 % TPB; const bool first = (ts == 0 || ts == SEQ), last = (ts + 32 == SEQ || ts + 32 == TPB);
#pragma unroll 1
        for (int rb = 0; rb < 32; rb += 8) {
            v4u gl[10], vl[8];
#pragma unroll
            for (int k = 0; k < 10; ++k) { const int r = rb - 1 + k; const bool zero = (r < 0 && first) || (r >= 32 && last);
                gl[k] = zero ? (v4u){0u, 0u, 0u, 0u} : *(const v4u*)(GV + (size_t)(r0 + r) * NUP + j0); }
#pragma unroll
            for (int k = 0; k < 8; ++k) vl[k] = *(const v4u*)(GV + (size_t)(r0 + rb + k) * NUP + FFH + j0);
#pragma unroll
            for (int k = 0; k < 8; ++k) {
                const unsigned gpa[4] = {gl[k].x, gl[k].y, gl[k].z, gl[k].w}, gca[4] = {gl[k + 1].x, gl[k + 1].y, gl[k + 1].z, gl[k + 1].w}, gna[4] = {gl[k + 2].x, gl[k + 2].y, gl[k + 2].z, gl[k + 2].w}, vva[4] = {vl[k].x, vl[k].y, vl[k].z, vl[k].w};
                unsigned oo[4];
#pragma unroll
                for (int q = 0; q < 4; ++q) {
                    const float ga = w0[2 * q] * bflo(gpa[q]) + w1[2 * q] * bflo(gca[q]) + w2[2 * q] * bflo(gna[q]) + bb[2 * q];
                    const float gb = w0[2 * q + 1] * bfhi(gpa[q]) + w1[2 * q + 1] * bfhi(gca[q]) + w2[2 * q + 1] * bfhi(gna[q]) + bb[2 * q + 1];
                    const float sa = ga / (1.f + __expf(-ga)), sb = gb / (1.f + __expf(-gb));
                    oo[q] = pk2(sa * bflo(vva[q]), sb * bfhi(vva[q])); }
                if (dry && oo[0] != 0x12345678u) { oo[0] = vva[0]; oo[1] = vva[1]; oo[2] = vva[2]; oo[3] = vva[3]; }
                *(v4u*)(GV + (size_t)(r0 + rb + k) * NUP + FFH + j0) = (v4u){oo[0], oo[1], oo[2], oo[3]};
            }
        }
    }
}
#ifdef PROBE_SYNC
#define GSYNC() do { xcd_barrier(xbar); xcd_barrier(xbar); } while (0)
#else
#define GSYNC() xcd_barrier(xbar)
#endif
#define GSYNC_CG() do { asm volatile("s_waitcnt vmcnt(0) lgkmcnt(0)" ::: "memory"); grid.sync(); __builtin_amdgcn_fence(__ATOMIC_ACQUIRE, "agent"); } while (0)
#if defined(NO_GEMM) || defined(NO_GEMM1)
#define GEMMCALL1 if (0)
#else
#define GEMMCALL1
#endif
#if defined(NO_GEMM) || defined(NO_GEMM2)
#define GEMMCALL2 if (0)
#else
#define GEMMCALL2
#endif
#if defined(NO_GEMM) || defined(NO_GEMM3)
#define GEMMCALL3 if (0)
#else
#define GEMMCALL3
#endif
#if defined(NO_GEMM) || defined(NO_GEMM4)
#define GEMMCALL4 if (0)
#else
#define GEMMCALL4
#endif
__global__ void __launch_bounds__(NTHREADS, 2) hybrid_fwd(Args a) {
    extern __shared__ __attribute__((aligned(16))) unsigned char lds[];
    cg::grid_group grid = cg::this_grid();
    Frame F;
    F.lds = (LAS unsigned char*)lds; F.tid = threadIdx.x; F.lane = F.tid & 63; F.wave = __builtin_amdgcn_readfirstlane(F.tid >> 6); F.G = gridDim.x; F.bid = blockIdx.x; F.wave0 = F.wave;

    { volatile LAS unsigned* misc = (volatile LAS unsigned*)(F.lds + MISC_OFF); if (F.tid < 32) misc[F.tid] = 0u; }
    __syncthreads();
    XcdBarrier xbar = xcd_barrier_post((unsigned*)(a.ws + WS_CTL) + CW_BAR, (volatile LAS unsigned*)(F.lds + MISC_OFF) + 8);
#ifndef NO_P0
    p0_prologue(F, a);
#endif
#ifdef PROBE_P0
    __syncthreads(); p0_prologue(F, a);
#endif

    { int never = 0; asm volatile("" : "+s"(never)); if (never) GSYNC_CG(); }
    GSYNC();
#define SITE() int lz = 0; asm volatile("" : "+s"(lz)); unsigned char* ws = (unsigned char*)((unsigned long long)a.ws ^ (unsigned long long)(unsigned)lz); (void)ws; \
    int bidl = F.bid; asm volatile("" : "+s"(bidl)); (void)bidl; \
    float* MODS = (float*)(ws + WS_MODS); float* XC = (float*)(ws + WS_XC); bf16* H = (bf16*)(ws + WS_H); bf16* U = (bf16*)(ws + WS_U); bf16* GV = (bf16*)(ws + WS_GV); \
    const float* xl_src = l == 0 ? a.in[lz + I_X] : a.out; const float* xc_src = l == 0 ? a.in[lz + I_CTX] : XC; const float* mods_l = MODS + (size_t)l * 5 * 6144; \
    (void)H; (void)U; (void)GV; (void)xl_src; (void)xc_src; (void)mods_l
#pragma nounroll
    for (int l = 0; l < 4; ++l) {
        const int even = !(l & 1);
        { SITE(); norm_phase(F, xl_src, xc_src, mods_l, 0, H); }
        weights_phase(F, a, l);
        __syncthreads();
        if (!even) filter_phase(F, a, l);
#ifdef PROBE_FILT
        if (!even) { __syncthreads(); filter_phase(F, a, l); }
#endif
        GSYNC();
        { SITE(); const int nin = even ? NIN_E : NIN_O; pg8::Gemm g{H, 1024, (const bf16*)(ws + WS_WIN), MROWS, nin, 1024}; pg8::StaticOrder S; S.init(MROWS, nin, F.G, bidl, even);
          EpiStore E{U, nin}; pg8::gemm_phase<EpiStore, pg8::StaticOrder, true, true>(F.lds, g, S, E, F.wave0);
          if (even) ctx_strip_gemm(F, H, 1024, (const bf16*)(ws + WS_WIN), 1024, nullptr, nullptr, nullptr, NIN_E / 64, U, NIN_E); }
        GSYNC();
#ifdef PROBE_QKN
        { SITE(); qknorm_phase(F, a, l, U, 1); }
#endif
        { SITE(); qknorm_phase(F, a, l, U); if (!even) hyprep_phase(F, a, l, U); }
        GSYNC();
#ifdef PROBE_MIXO
        for (int rep = 0; rep < (even ? 1 : 2); ++rep) { mixer_phase(F, a, l, (char*)lds, l + 4 * rep, (!even && rep == 0) ? 1 : 0); GSYNC(); }
#else
        mixer_phase(F, a, l, (char*)lds, l, 0);
        GSYNC();
#endif
        if (even) dacombine_phase(F, a, l); else hypost_phase(F, a, l);
        GSYNC();
        { SITE(); pg8::Gemm g{H, 1024, (const bf16*)(ws + WS_WOUT), MROWS, 1024, 1024}; pg8::StaticOrder S; S.init(MROWS, 1024, F.G, bidl, 1);
          EpiResid E{xl_src, xc_src, a.out, XC, mods_l + 2048};
#ifdef PROBE_GEMM2
          for (int rep = 0; rep < 2; ++rep) { int zi = rep; asm volatile("" : "+s"(zi)); E.mul = (float)zi; if (rep == 0) { E.dl = (float*)xl_src; E.dc = (float*)xc_src; } else { E.dl = a.out; E.dc = XC; } pg8::gemm_phase<EpiResid, pg8::StaticOrder, true, true>(F.lds, g, S, E, F.wave0); if (rep == 0) GSYNC(); }
#else
          pg8::gemm_phase<EpiResid, pg8::StaticOrder, true, true>(F.lds, g, S, E, F.wave0);
#endif
          if (l < 3) ctx_strip_gemm(F, H, 1024, (const bf16*)(ws + WS_WOUT), 1024, xc_src, XC, mods_l + 4 * 6144 + 2048); }
        GSYNC();
        { SITE(); norm_phase(F, a.out, XC, mods_l, 3072, H); }
        GSYNC();
        { SITE(); pg8::Gemm g{H - 1024, 1024, (const bf16*)(ws + WS_WUP), 137 * 256, NUP, 1024, 1}; pg8::StaticOrder S; S.init(137 * 256, NUP, F.G, bidl);
          EpiConv E{GV, a.in[lz + I_FCW] + (size_t)l * 3 * FFH, a.in[lz + I_FCB] + (size_t)l * FFH}; pg8::gemm_phase<EpiConv, pg8::StaticOrder, true, true>(F.lds, g, S, E, F.wave0); }
        GSYNC();
        { SITE(); pg8::Gemm g{GV, FFH, (const bf16*)(ws + WS_WDOWN), MROWS, 1024, FFH}; pg8::StaticOrder S; S.init(MROWS, 1024, F.G, bidl, 1);
          EpiResid E{a.out, XC, a.out, XC, mods_l + 5120};
#ifdef PROBE_GEMM2
          for (int rep = 0; rep < 2; ++rep) { int zi = rep; asm volatile("" : "+s"(zi)); E.mul = (float)zi; pg8::gemm_phase<EpiResid, pg8::StaticOrder, true, true>(F.lds, g, S, E, F.wave0); if (rep == 0) GSYNC(); }
#else
          pg8::gemm_phase<EpiResid, pg8::StaticOrder, true, true>(F.lds, g, S, E, F.wave0);
#endif
          if (l < 3) ctx_strip_gemm(F, GV, FFH, (const bf16*)(ws + WS_WDOWN), FFH, XC, XC, mods_l + 4 * 6144 + 5120); }
        GSYNC();
    }
}

extern "C" void kernel_launch(void* const* d_in, const int* in_sizes, int n_in, void* d_out, int out_size, void* d_ws, size_t ws_size, hipStream_t stream) {
    static int grid = 0;
    if (grid == 0) {
        if (n_in != 37 || out_size != NBATCH * SEQ * DMODEL || ws_size < WS_END) { fprintf(stderr, "kernel_launch: unexpected problem (n_in %d out %d ws %zu)\n", n_in, out_size, ws_size); grid = -1; return; }
        int dev = 0, cus = 0, per_cu = 0;
        if (hipGetDevice(&dev) != hipSuccess || hipDeviceGetAttribute(&cus, hipDeviceAttributeMultiprocessorCount, dev) != hipSuccess) { grid = -1; return; }
        if (hipFuncSetAttribute((const void*)hybrid_fwd, hipFuncAttributeMaxDynamicSharedMemorySize, LDS_BYTES) != hipSuccess) { fprintf(stderr, "kernel_launch: hipFuncSetAttribute failed\n"); grid = -1; return; }
        if (hipOccupancyMaxActiveBlocksPerMultiprocessor(&per_cu, (const void*)hybrid_fwd, NTHREADS, LDS_BYTES) != hipSuccess || per_cu < 1) { fprintf(stderr, "kernel_launch: occupancy query says %d\n", per_cu); }
        (void)hipGetLastError();
        grid = cus;
    }
    if (grid < 0) return;
    if (hipMemsetAsync((char*)d_ws + WS_CTL, 0, CTL_ZERO_BYTES, stream) != hipSuccess) { fprintf(stderr, "kernel_launch: memset failed\n"); return; }
    Args a{};
    for (int i = 0; i < 37; ++i) a.in[i] = (const float*)d_in[i];
    a.out = (float*)d_out; a.ws = (unsigned char*)d_ws;
    void* args[] = {&a};
    hipError_t e = hipLaunchCooperativeKernel((const void*)hybrid_fwd, dim3(grid), dim3(NTHREADS), args, LDS_BYTES, stream);
    if (e != hipSuccess) fprintf(stderr, "kernel_launch: cooperative launch failed: %s (grid %d)\n", hipGetErrorString(e), grid);
}
```
